# Optimizing an MI355X kernel written in HIP

```python
import jax, jax.numpy as jnp
from jax import lax
import numpy as np

D_MODEL = 2048
BATCH = 4
SEQ = 2048
DEPTH = 2
DEC_BATCH = 128
DEC_SEQ = 1
PAST_LEN = 8192
PAGE_SIZE = 128

BRANCH_W = D_MODEL // 2
HEAD_DIM = 64
N_HEADS = BRANCH_W // HEAD_DIM
N_KV_HEADS = 4
GQA_GROUP = N_HEADS // N_KV_HEADS
KV_W = N_KV_HEADS * HEAD_DIM
WINDOW = 128
D_CONV = BRANCH_W
CONV_WIDTH = 3
D_GMLP = BRANCH_W
CHUNK = 128
N_SPATIAL_GROUPS = 8
SPATIAL_GROUP_W = D_GMLP // N_SPATIAL_GROUPS
N_BRANCHES = 3
D_FF = -(-8 * D_MODEL // (3 * 256)) * 256
COL_SIZES = (BRANCH_W, KV_W, KV_W, D_CONV, D_CONV, D_CONV, D_GMLP, D_GMLP, N_BRANCHES * D_MODEL)
IN_COLS = sum(COL_SIZES)
EPS = 1e-6
NEG_INF = -1e30

kernel_name = "hybrid_swa_shortconv_gmlp_gated_decoder_step"


def rms_norm(x, g):
    xf = x.astype(jnp.float32)
    y = xf * lax.rsqrt(jnp.mean(xf * xf, axis=-1, keepdims=True) + EPS)
    return (y * g.astype(jnp.float32)).astype(x.dtype)


def alibi_slopes():
    return jnp.exp2(-8.0 * jnp.arange(1, N_HEADS + 1, dtype=jnp.float32) / N_HEADS)


def split_cols(z):
    idx = np.cumsum(np.array(COL_SIZES))[:-1].tolist()
    return jnp.split(z, idx, axis=-1)


def window_attend(q, k, v, q_pos, k_pos, sinks):
    Bn, N, Tq = q.shape[:3]
    qg = q.reshape(Bn, N, Tq, N_KV_HEADS, GQA_GROUP, HEAD_DIM)
    s = jnp.einsum("bnqkgd,bnskd->bnkgqs", qg, k, preferred_element_type=jnp.float32) * (HEAD_DIM ** -0.5)
    dist = q_pos[:, :, None] - k_pos[:, None, :]
    valid = (k_pos[:, None, :] >= 0) & (dist >= 0) & (dist < WINDOW)
    slopes = alibi_slopes().reshape(N_KV_HEADS, GQA_GROUP)
    bias = -slopes[None, :, :, None, None] * dist.astype(jnp.float32)[:, None, None]
    s = jnp.where(valid[:, None, None], s + bias, NEG_INF)
    sink = sinks.astype(jnp.float32).reshape(N_KV_HEADS, GQA_GROUP)[None, None, :, :, None, None]
    sink = jnp.broadcast_to(sink, s.shape[:-1] + (1,))
    p = jax.nn.softmax(jnp.concatenate([s, sink], axis=-1), axis=-1)[..., :-1]
    o = jnp.einsum("bnkgqs,bnskd->bnqkgd", p.astype(v.dtype), v)
    return o.reshape(Bn, N, Tq, BRANCH_W)


def prompt_window_attention(q, k, v, sinks):
    Bn, T = q.shape[:2]
    nb = T // WINDOW
    qb = q.reshape(Bn, nb, WINDOW, N_HEADS, HEAD_DIM)

    def band(xb):
        prev = jnp.concatenate([jnp.zeros_like(xb[:, :1]), xb[:, :-1]], axis=1)
        return jnp.concatenate([prev, xb], axis=2)

    kb = band(k.reshape(Bn, nb, WINDOW, N_KV_HEADS, HEAD_DIM))
    vb = band(v.reshape(Bn, nb, WINDOW, N_KV_HEADS, HEAD_DIM))
    pos = jnp.arange(T, dtype=jnp.int32).reshape(nb, WINDOW)
    k_pos = jnp.concatenate([pos - WINDOW, pos], axis=1)
    return window_attend(qb, kb, vb, pos, k_pos, sinks).reshape(Bn, T, BRANCH_W)


def sample_window_attention(q, k, v, k_buf, v_buf, sinks):
    Bn, T = q.shape[:2]
    n_buf = k_buf.shape[1]
    k_all = jnp.concatenate([k_buf, k], axis=1)[:, None]
    v_all = jnp.concatenate([v_buf, v], axis=1)[:, None]
    q_pos = PAST_LEN + jnp.arange(T, dtype=jnp.int32)
    k_pos = jnp.concatenate([PAST_LEN - n_buf + jnp.arange(n_buf, dtype=jnp.int32), q_pos])
    o = window_attend(q[:, None], k_all, v_all, q_pos[None], k_pos[None], sinks)
    return o.reshape(Bn, T, BRANCH_W)


def short_conv(z_pad, w, T):
    return sum(w[j] * z_pad[:, j:j + T] for j in range(CONV_WIDTH))


def spatial_mix(v, w_s, b_s):
    T = v.shape[2]
    mask = jnp.tril(jnp.ones((T, T), dtype=bool))
    w = jnp.where(mask[None], w_s[:, :T, :T], jnp.zeros((), w_s.dtype))
    return jnp.einsum("gpq,bnqgc->bnpgc", w, v) + b_s[:, :T].T[None, None, :, :, None]


def layer(x, lw, is_prompt, k_buf=None, v_buf=None, conv_buf=None):
    (norm_mix, w_in, b_gate, q_norm, k_norm, sinks, conv_w, v_norm,
     w_spatial, b_spatial, w_branch, w_out, norm_ffn, w_gate_up, w_down) = lw
    Bn, T, _ = x.shape
    xn = rms_norm(x, norm_mix)
    q, k, v, bg, cg, h, u, vg, g = split_cols(xn @ w_in)

    q = rms_norm(q.reshape(Bn, T, N_HEADS, HEAD_DIM), q_norm)
    k = rms_norm(k.reshape(Bn, T, N_KV_HEADS, HEAD_DIM), k_norm)
    v = v.reshape(Bn, T, N_KV_HEADS, HEAD_DIM)
    if is_prompt:
        o_a = prompt_window_attention(q, k, v, sinks)
        keep = min(WINDOW, T)
        new_k, new_v = k[:, T - keep:], v[:, T - keep:]
    else:
        o_a = sample_window_attention(q, k, v, k_buf, v_buf, sinks)
        new_k, new_v = k, v

    zc = cg * h
    if is_prompt:
        z_pad = jnp.concatenate([jnp.zeros((Bn, CONV_WIDTH - 1, D_CONV), zc.dtype), zc], axis=1)
    else:
        z_pad = jnp.concatenate([conv_buf, zc], axis=1)
    o_b = bg * short_conv(z_pad, conv_w, T)
    new_conv = z_pad[:, -(CONV_WIDTH - 1):]

    u = jax.nn.gelu(u)
    vg = rms_norm(jax.nn.gelu(vg), v_norm)
    n_chunks = T // CHUNK if is_prompt else 1
    vc = vg.reshape(Bn, n_chunks, T // n_chunks, N_SPATIAL_GROUPS, SPATIAL_GROUP_W)
    o_c = u * spatial_mix(vc, w_spatial, b_spatial).reshape(Bn, T, D_GMLP)

    branches = jnp.stack([o_a, o_b, o_c], axis=2)
    proj = jnp.einsum("btic,icd->btid", branches, w_branch)
    gates = jax.nn.sigmoid(g.reshape(Bn, T, N_BRANCHES, D_MODEL) + b_gate)
    x = x + jnp.sum(gates * proj, axis=2) @ w_out

    gate, up = jnp.split(rms_norm(x, norm_ffn) @ w_gate_up, 2, axis=-1)
    x = x + (jax.nn.silu(gate) * up) @ w_down
    return x, new_k, new_v, new_conv, vg


def setup_inputs(seed: int = 0) -> dict:
    key = jax.random.key(seed)
    ks = jax.random.split(key, 24)
    f32 = jnp.float32
    n = lambda k, shape, s: jax.random.normal(k, shape, f32) * s
    w_buf = min(WINDOW, PAST_LEN)
    return {
        "x_prompt": n(ks[0], (BATCH, SEQ, D_MODEL), 1.0),
        "x_sample": n(ks[1], (DEC_BATCH, DEC_SEQ, D_MODEL), 1.0),
        "cache_k": n(ks[2], (DEPTH, DEC_BATCH, w_buf, N_KV_HEADS, HEAD_DIM), 1.0),
        "cache_v": n(ks[3], (DEPTH, DEC_BATCH, w_buf, N_KV_HEADS, HEAD_DIM), 1.0),
        "state_conv": n(ks[4], (DEPTH, DEC_BATCH, CONV_WIDTH - 1, D_CONV), 1.0),
        "norm_mix": 1.0 + n(ks[5], (DEPTH, D_MODEL), 0.05),
        "w_in": n(ks[6], (DEPTH, D_MODEL, IN_COLS), D_MODEL ** -0.5),
        "b_gate": n(ks[7], (DEPTH, N_BRANCHES, D_MODEL), 0.1),
        "q_norm": 1.0 + n(ks[8], (DEPTH, HEAD_DIM), 0.05),
        "k_norm": 1.0 + n(ks[9], (DEPTH, HEAD_DIM), 0.05),
        "sinks": n(ks[10], (DEPTH, N_HEADS), 0.5),
        "conv_w": n(ks[11], (DEPTH, CONV_WIDTH, D_CONV), CONV_WIDTH ** -0.5),
        "v_norm": 1.0 + n(ks[12], (DEPTH, D_GMLP), 0.05),
        "w_spatial": n(ks[13], (DEPTH, N_SPATIAL_GROUPS, CHUNK, CHUNK), CHUNK ** -0.5),
        "b_spatial": 1.0 + n(ks[14], (DEPTH, N_SPATIAL_GROUPS, CHUNK), 0.1),
        "w_branch": n(ks[15], (DEPTH, N_BRANCHES, BRANCH_W, D_MODEL), BRANCH_W ** -0.5),
        "w_out": n(ks[16], (DEPTH, D_MODEL, D_MODEL), D_MODEL ** -0.5),
        "norm_ffn": 1.0 + n(ks[17], (DEPTH, D_MODEL), 0.05),
        "w_gate_up": n(ks[18], (DEPTH, D_MODEL, 2 * D_FF), D_MODEL ** -0.5),
        "w_down": n(ks[19], (DEPTH, D_FF, D_MODEL), D_FF ** -0.5),
    }


def reference(x_prompt, x_sample, cache_k, cache_v, state_conv, norm_mix, w_in, b_gate, q_norm, k_norm,
              sinks, conv_w, v_norm, w_spatial, b_spatial, w_branch, w_out, norm_ffn, w_gate_up, w_down):
    weights = (norm_mix, w_in, b_gate, q_norm, k_norm, sinks, conv_w, v_norm,
               w_spatial, b_spatial, w_branch, w_out, norm_ffn, w_gate_up, w_down)
    xp, xs = x_prompt, x_sample
    kp, vp, cp, ksm, vsm, csm, gsm = [], [], [], [], [], [], []
    for l in range(DEPTH):
        lw = tuple(a[l] for a in weights)
        xp, k1, v1, c1, _ = layer(xp, lw, True)
        xs, k2, v2, c2, g2 = layer(xs, lw, False, cache_k[l], cache_v[l], state_conv[l])
        kp.append(k1); vp.append(v1); cp.append(c1)
        ksm.append(k2); vsm.append(v2); csm.append(c2); gsm.append(g2)
    return (xp, xs, jnp.stack(kp), jnp.stack(vp), jnp.stack(cp),
            jnp.stack(ksm), jnp.stack(vsm), jnp.stack(csm), jnp.stack(gsm))
```

```cpp
#include <hip/hip_runtime.h>
#include <hip/hip_cooperative_groups.h>
#include <cstdio>
#include <cstdint>
namespace cg = cooperative_groups;
namespace pg8 {
#define PG8_LAS __attribute__((address_space(3)))
typedef unsigned short bf16_t;
typedef short bf16x8 __attribute__((ext_vector_type(8)));
typedef float f32x4 __attribute__((ext_vector_type(4)));
typedef unsigned u32x4 __attribute__((ext_vector_type(4)));
constexpr int BM = 256, BK = 64, HALF = 128, HTB = HALF * BK * 2  , STAGE_BYTES = 8 * HTB, NXCD = 8, WGM = 8;

__host__ __device__ __forceinline__ int lds_byte(int r, int c) { const int st = (r >> 4) * 2 + (c >> 5), rr = r & 15, cc = c & 31, ob = rr * 64 + cc * 2; return st * 1024 + (ob ^ (((ob >> 9) & 1) << 5)); }
__host__ __device__ __forceinline__ void stage_rc(int b, int& R, int& C) { const int st = b / 1024, sb = b % 1024, swz = sb ^ (((sb >> 9) & 1) << 5); R = (st >> 1) * 16 + swz / 64; C = (st & 1) * 32 + (swz % 64) / 2; }
__host__ __device__ __forceinline__ int perm32(int rho) { const int n = rho >> 4, i = rho & 15; return 8 * (i >> 2) + 4 * n + (i & 3); }

struct Unit { int pm, pn, k0, nt, part, ab; };
struct Gemm { const bf16_t* A; const bf16_t* Bt; int M, N, K; size_t sA, sB; };

struct StaticOrder {
    int nM, nN, nwg, G, c, ntk;
    __host__ __device__ __forceinline__ void init(int M, int N, int K, int G_, int c_) { nM = M / BM; nN = N / BM; nwg = nM * nN; G = G_; c = c_; ntk = K / BK; }
    __host__ __device__ __forceinline__ bool next(int i, Unit& u) const {
        const long L = (long)i * G + c; if (L >= nwg) return false;
        u.k0 = 0; u.nt = ntk; u.part = -1; u.ab = 0;
        int wgid = (int)L; { const int q = nwg / NXCD, r = nwg % NXCD, xcd = wgid % NXCD, off = wgid / NXCD; wgid = (xcd < r ? xcd * (q + 1) : r * (q + 1) + (xcd - r) * q) + off; }
        const int nig = WGM * nN, gid = wgid / nig, fm = gid * WGM, gsz = (nM - fm) < WGM ? (nM - fm) : WGM;
        u.pm = fm + ((wgid % nig) % gsz); u.pn = (wgid % nig) / gsz; return true;
    }
    __device__ __forceinline__ void a_ready(const Unit&) const {}
    __device__ __forceinline__ void done(const Unit&) const {}
};

struct TailOrder {
    int nM, nN, nfull, nmini, G, c, ntk;
    __host__ __device__ __forceinline__ void init(int Mfull, int N, int K, int G_, int c_) { nM = Mfull / BM; nN = N / BM; nfull = nM * nN; nmini = nN * (K / 256); G = G_; c = c_; ntk = K / BK; }
    __host__ __device__ __forceinline__ bool next(int i, Unit& u) const {
        const int L = i * G + c;
        const bool full = L < nfull, ok = L < nfull + nmini;
        int wgid = full ? L : 0; { const int q = nfull / NXCD, r = nfull % NXCD, xcd = wgid % NXCD, off = wgid / NXCD; wgid = (xcd < r ? xcd * (q + 1) : r * (q + 1) + (xcd - r) * q) + off; }
        const int nig = WGM * nN, gid = wgid / nig, fm = gid * WGM, gsz = (nM - fm) < WGM ? (nM - fm) : WGM;
        const int fpm = fm + ((wgid % nig) % gsz), fpn = (wgid % nig) / gsz;
        const int j = L - nfull, mpn = j % nN, mks = j / nN;
        Unit r_; r_.pm = full ? fpm : nM; r_.pn = full ? fpn : mpn; r_.k0 = full ? 0 : mks * 256; r_.nt = full ? ntk : 4; r_.part = full ? -1 : mks; r_.ab = 0;
        u = r_; return ok;
    }
    __device__ __forceinline__ void a_ready(const Unit&) const {}
    __device__ __forceinline__ void done(const Unit&) const {}
};
struct BranchOrder {
    int nN, G, c, ntk;
    __host__ __device__ __forceinline__ void init(int N, int K, int G_, int c_) { nN = N / BM; G = G_; c = c_; ntk = K / BK; }
    __host__ __device__ __forceinline__ bool next(int i, Unit& u) const {
        const bool full = i < 3, ok = full || (i == 3 && c < 96);
        int wgid = c; { const int nfull = 256, q = nfull / NXCD, xcd = wgid % NXCD, off = wgid / NXCD; wgid = xcd * q + off; }
        const int nig = WGM * nN, gid = wgid / nig, fm = gid * WGM;
        const int fpm = fm + ((wgid % nig) % WGM), fpn = (wgid % nig) / WGM;
        const int jj = c & 31, mpn = jj % nN, mks = jj / nN;
        Unit r_; r_.pm = full ? fpm : 32; r_.pn = full ? fpn : mpn; r_.k0 = full ? 0 : mks * 256; r_.nt = full ? ntk : 4; r_.part = full ? -1 : mks; r_.ab = full ? i : (c >> 5);
        u = r_; return ok;
    }
    __device__ __forceinline__ void a_ready(const Unit&) const {}
    __device__ __forceinline__ void done(const Unit&) const {}
};
__device__ __forceinline__ unsigned cvt_pk_bf16(float lo, float hi) { unsigned r; asm volatile("v_cvt_pk_bf16_f32 %0, %1, %2" : "=v"(r) : "v"(lo), "v"(hi)); return r; }
typedef float f32x2 __attribute__((ext_vector_type(2)));
template <class Epi, class Sched, bool ALIGN_EPI = false, bool SP2 = false>
__device__ __forceinline__ void gemm_phase(PG8_LAS unsigned char* lds, const Gemm g, const Sched& S, const Epi& E) {
    int tid0_ = threadIdx.x; asm volatile("" : "+v"(tid0_)); const int tid = tid0_, wid = __builtin_amdgcn_readfirstlane(tid >> 6), lane = tid & 63, wr = wid >> 2, wc = wid & 3, fr = lane & 15, fq = lane >> 4;
    const int K = g.K;
    unsigned voffA[2], voffB[2];
#pragma unroll
    for (int i = 0; i < 2; ++i) { int R, C; stage_rc(tid * 16 + i * 8192, R, C); const int Rb = Epi::PERM ? ((R & ~31) + perm32(R & 31)) : R;
        voffA[i] = (unsigned)(R * K + C) * 2u; voffB[i] = (unsigned)(Rb * K + C) * 2u; }
    const size_t kstep = (size_t)(BK * 2);
    const size_t hstep = (size_t)HALF * K * 2;
    const size_t tstep = 2 * hstep;
    const unsigned ldsw = (unsigned)wid * 1024u;
    const int aoff = lds_byte(wr * 64 + fr, fq * 8), boff = lds_byte(wc * 32 + fr, fq * 8);
#define PG8_SA(b, h) (((b) * 2 + (h)) * HTB)
#define PG8_SB(b, h) ((4 + (b) * 2 + (h)) * HTB)
#define PG8_STAGE(bufoff, gbase, voff) do { _Pragma("unroll") for (int _i = 0; _i < 2; ++_i) \
        __builtin_amdgcn_global_load_lds((const unsigned*)((const char*)(gbase) + (voff)[_i]), (PG8_LAS unsigned*)(lds + (bufoff) + ldsw + _i * 8192), 16, 0, 0); } while (0)
#define PG8_LDA(dst, b, h) do { _Pragma("unroll") for (int m = 0; m < 4; ++m) _Pragma("unroll") for (int k = 0; k < 2; ++k) dst[m][k] = *(const PG8_LAS bf16x8*)(lds + PG8_SA(b, h) + aoff + m * 2048 + k * 1024); } while (0)
#define PG8_LDB(dst, b, h) do { _Pragma("unroll") for (int n = 0; n < 2; ++n) _Pragma("unroll") for (int k = 0; k < 2; ++k) dst[n][k] = *(const PG8_LAS bf16x8*)(lds + PG8_SB(b, h) + boff + n * 2048 + k * 1024); } while (0)
#define PG8_MMA(ai, bj, At, Bt) do { __builtin_amdgcn_s_setprio(1); _Pragma("unroll") for (int m = 0; m < 4; ++m) _Pragma("unroll") for (int n = 0; n < 2; ++n) _Pragma("unroll") for (int k = 0; k < 2; ++k) \
        acc[ai][bj][m][n] = __builtin_amdgcn_mfma_f32_16x16x32_bf16(Bt[n][k], At[m][k], acc[ai][bj][m][n], 0, 0, 0); __builtin_amdgcn_s_setprio(0); } while (0)
#define PG8_WAIT_V(n) asm volatile("s_waitcnt vmcnt(" #n ")" ::: "memory")
#define PG8_WAIT_L(n) asm volatile("s_waitcnt lgkmcnt(" #n ")" ::: "memory")
#define PG8_BAR __builtin_amdgcn_s_barrier()
#define PG8_SCHED __builtin_amdgcn_sched_barrier(0)
    Unit cur, nxt; int ui = 0;
    if (!S.next(0, cur)) return;
    f32x4 acc[2][2][4][2];
    float epre[8];
#pragma unroll
    for (int i_ = 0; i_ < 8; ++i_) epre[i_] = 0.f;
#pragma unroll
    for (int a = 0; a < 2; ++a)
#pragma unroll
        for (int b = 0; b < 2; ++b)
#pragma unroll
            for (int m = 0; m < 4; ++m)
#pragma unroll
                for (int n = 0; n < 2; ++n) acc[a][b][m][n] = (f32x4){0.f, 0.f, 0.f, 0.f};
    bf16x8 At[4][2], B0[2][2], B1[2][2];
    const char* cA = (const char*)g.A + (size_t)cur.ab * g.sA + (size_t)cur.pm * tstep + (size_t)cur.k0 * 2; const char* cB = (const char*)g.Bt + (size_t)cur.ab * g.sB + (size_t)cur.pn * tstep + (size_t)cur.k0 * 2;
    S.a_ready(cur);
    if constexpr (SP2) {
        PG8_STAGE(PG8_SB(0, 0), cB, voffB); PG8_STAGE(PG8_SB(0, 1), cB + hstep, voffB); PG8_STAGE(PG8_SA(0, 0), cA, voffA); PG8_STAGE(PG8_SA(0, 1), cA + hstep, voffA);
        if (wr == 1) PG8_BAR;
        PG8_WAIT_V(2); PG8_BAR;
        PG8_STAGE(PG8_SB(1, 0), cB + kstep, voffB); PG8_STAGE(PG8_SA(1, 0), cA + kstep, voffA); PG8_STAGE(PG8_SB(1, 1), cB + hstep + kstep, voffB);
        PG8_WAIT_V(6); PG8_BAR;
    } else {
        PG8_STAGE(PG8_SB(0, 0), cB, voffB); PG8_STAGE(PG8_SA(0, 0), cA, voffA); PG8_STAGE(PG8_SB(0, 1), cB + hstep, voffB); PG8_STAGE(PG8_SA(0, 1), cA + hstep, voffA);
        if (wr == 1) PG8_BAR;
        PG8_WAIT_V(4); PG8_BAR;
        PG8_STAGE(PG8_SB(1, 0), cB + kstep, voffB); PG8_STAGE(PG8_SA(1, 0), cA + kstep, voffA); PG8_STAGE(PG8_SB(1, 1), cB + hstep + kstep, voffB);
        PG8_WAIT_V(6); PG8_BAR;
    }
    for (;;) {
        const bool has_next = S.next(ui + 1, nxt);
        const char* nA = has_next ? (const char*)g.A + (size_t)nxt.ab * g.sA + (size_t)nxt.pm * tstep + (size_t)nxt.k0 * 2 : cA; const char* nB = has_next ? (const char*)g.Bt + (size_t)nxt.ab * g.sB + (size_t)nxt.pn * tstep + (size_t)nxt.k0 * 2 : cB;
        const int nt = cur.nt;
        for (int t = 0; t < nt; t += 2) {
            const bool last = (t == nt - 2);
            const char* a1 = cA + (size_t)(t + 1) * kstep;
            const char* a2 = last ? nA : cA + (size_t)(t + 2) * kstep; const char* b2 = last ? nB : cB + (size_t)(t + 2) * kstep;
            const char* a3 = a2 + kstep; const char* b3 = b2 + kstep;
            if (last && has_next) S.a_ready(nxt);
            if constexpr (Epi::PREFETCH) { if (last) E.pre(epre, cur, wr, fr); }
            if constexpr (SP2) {
            PG8_LDB(B0, 0, 0); PG8_LDB(B1, 0, 1); PG8_SCHED; PG8_LDA(At, 0, 0); PG8_STAGE(PG8_SA(1, 1), a1 + hstep, voffA);
            PG8_WAIT_V(8); PG8_WAIT_L(0); PG8_BAR; PG8_MMA(0, 0, At, B0); PG8_MMA(0, 1, At, B1); PG8_BAR; PG8_SCHED;
            PG8_LDA(At, 0, 1); PG8_STAGE(PG8_SB(0, 0), b2, voffB); PG8_STAGE(PG8_SB(0, 1), b2 + hstep, voffB); PG8_STAGE(PG8_SA(0, 0), a2, voffA);
            PG8_WAIT_V(8); PG8_WAIT_L(0); PG8_BAR; PG8_MMA(1, 0, At, B0); PG8_MMA(1, 1, At, B1); PG8_BAR; PG8_SCHED;
            PG8_LDB(B0, 1, 0); PG8_LDB(B1, 1, 1); PG8_SCHED; PG8_LDA(At, 1, 0); PG8_STAGE(PG8_SA(0, 1), a2 + hstep, voffA);
            PG8_WAIT_V(8); PG8_WAIT_L(0); PG8_BAR; PG8_MMA(0, 0, At, B0); PG8_MMA(0, 1, At, B1); PG8_BAR; PG8_SCHED;
            PG8_LDA(At, 1, 1); PG8_STAGE(PG8_SB(1, 0), b3, voffB); PG8_STAGE(PG8_SB(1, 1), b3 + hstep, voffB); PG8_STAGE(PG8_SA(1, 0), a3, voffA);
            PG8_WAIT_V(8); PG8_WAIT_L(0); PG8_BAR; PG8_MMA(1, 0, At, B0); PG8_MMA(1, 1, At, B1); PG8_BAR; PG8_SCHED;
            } else {
            PG8_LDB(B0, 0, 0); PG8_SCHED; PG8_LDA(At, 0, 0); PG8_STAGE(PG8_SA(1, 1), a1 + hstep, voffA);
            PG8_WAIT_L(8); PG8_BAR; PG8_WAIT_L(0); PG8_MMA(0, 0, At, B0); PG8_BAR; PG8_SCHED;
            PG8_LDB(B1, 0, 1); PG8_STAGE(PG8_SB(0, 0), b2, voffB);
            PG8_BAR; PG8_WAIT_L(0); PG8_MMA(0, 1, At, B1); PG8_BAR;
            PG8_LDA(At, 0, 1); PG8_STAGE(PG8_SA(0, 0), a2, voffA);
            PG8_BAR; PG8_WAIT_L(0); PG8_MMA(1, 0, At, B0); PG8_BAR; PG8_SCHED;
            PG8_STAGE(PG8_SB(0, 1), b2 + hstep, voffB);
            PG8_WAIT_V(6); PG8_BAR; PG8_MMA(1, 1, At, B1); PG8_BAR;
            PG8_LDB(B0, 1, 0); PG8_SCHED; PG8_LDA(At, 1, 0); PG8_STAGE(PG8_SA(0, 1), a2 + hstep, voffA);
            PG8_WAIT_L(8); PG8_BAR; PG8_WAIT_L(0); PG8_MMA(0, 0, At, B0); PG8_BAR; PG8_SCHED;
            PG8_LDB(B1, 1, 1); PG8_STAGE(PG8_SB(1, 0), b3, voffB);
            PG8_BAR; PG8_WAIT_L(0); PG8_MMA(0, 1, At, B1); PG8_BAR;
            PG8_LDA(At, 1, 1); PG8_STAGE(PG8_SA(1, 0), a3, voffA);
            PG8_BAR; PG8_WAIT_L(0); PG8_MMA(1, 0, At, B0); PG8_BAR; PG8_SCHED;
            PG8_STAGE(PG8_SB(1, 1), b3 + hstep, voffB);
            PG8_WAIT_V(6); PG8_BAR; PG8_MMA(1, 1, At, B1); PG8_BAR;
            }
        }
        if constexpr (ALIGN_EPI) { if (wr == 0) PG8_BAR; }
        if constexpr (!Epi::AFTER_DRAIN) { if constexpr (Epi::PREFETCH) E(acc, cur, wr, wc, fr, fq, epre); else E(acc, cur, wr, wc, fr, fq); S.done(cur); }
        if (!has_next) break;
#pragma unroll
        for (int a = 0; a < 2; ++a)
#pragma unroll
            for (int b = 0; b < 2; ++b)
#pragma unroll
                for (int m = 0; m < 4; ++m)
#pragma unroll
                    for (int n = 0; n < 2; ++n) acc[a][b][m][n] = (f32x4){0.f, 0.f, 0.f, 0.f};
        cur = nxt; cA = nA; cB = nB; ++ui;
        if constexpr (ALIGN_EPI) { if (wr == 1) PG8_BAR; }
    }
    PG8_WAIT_V(0);
    if constexpr (!ALIGN_EPI) { if (wr == 0) PG8_BAR; }
    PG8_BAR;
    if constexpr (Epi::AFTER_DRAIN) { E.fused(acc, cur, wr, wc, fr, fq, lds, wid, lane); S.done(cur); }
#undef PG8_SA
#undef PG8_SB
#undef PG8_STAGE
#undef PG8_LDA
#undef PG8_LDB
#undef PG8_MMA
#undef PG8_WAIT_V
#undef PG8_WAIT_L
#undef PG8_BAR
#undef PG8_SCHED
}
}

#ifndef MK_N_LAUNCHES
#define MK_N_LAUNCHES 1
#endif
#define LAS __attribute__((address_space(3)))
#define GAS __attribute__((address_space(1)))
using pg8::f32x4; using pg8::bf16_t; using pg8::Unit; using pg8::u32x4; using pg8::bf16x8;
typedef unsigned u32x2 __attribute__((ext_vector_type(2)));

constexpr int DM = 2048, TP = 8192, MTOT = 8320, MPAD = 8448, INC = 12800, DFF = 5632;
constexpr float EPS = 1e-6f;
constexpr size_t O_NKP = 17039360, O_NVP = 17301504, O_NCP = 17563648, O_NKS = 17580032, O_NVS = 17645568, O_NCS = 17711104, O_NGS = 18235392;
constexpr size_t WE_IN = (size_t)INC * DM, WE_BR = (size_t)3 * 2048 * 1024, WE_OUT = (size_t)DM * DM, WE_GU = (size_t)2 * DFF * DM, WE_DN = (size_t)DM * DFF;
constexpr size_t WE_LAYER = WE_IN + WE_BR + WE_OUT + WE_GU + WE_DN;
constexpr size_t WS_SSV = 0;
constexpr size_t WS_W = 1u << 20;
constexpr size_t WS_X = WS_W + 2 * WE_LAYER * 2;
constexpr size_t WS_XN = WS_X + (size_t)MPAD * DM * 4;
constexpr size_t WS_A = WS_XN + (size_t)MPAD * DM * 2;
constexpr size_t SZ1K = (size_t)MPAD * 1024 * 2;
constexpr size_t WS_Q = WS_A, WS_K = WS_Q + SZ1K, WS_V = WS_K + SZ1K / 4, WS_BG = WS_V + SZ1K / 4, WS_ZC = WS_BG + SZ1K, WS_U = WS_ZC + SZ1K, WS_VG = WS_U + SZ1K;
constexpr size_t WS_GT = WS_VG + SZ1K;
constexpr size_t WS_OA = WS_GT + (size_t)MPAD * 6144 * 2, WS_OB = WS_OA + SZ1K, WS_OC = WS_OB + SZ1K;
constexpr size_t WS_MG = WS_OC + SZ1K;
constexpr size_t WS_END = WS_MG + (size_t)MPAD * DM * 2;
constexpr size_t WS_TMP = WS_A;
constexpr size_t WS_H = WS_A;
static_assert((size_t)MPAD * DM * 4 <= WS_GT - WS_A && (size_t)MPAD * DFF * 2 <= WS_GT - WS_A, "overlay");
constexpr size_t WS_BAR = 0xA0000, WS_ZERO_LO = 0x90000, WS_ZERO_BYTES = 0x14000;
constexpr size_t WS_CNT = 0x90000;
constexpr size_t WS_PART = WS_END;
constexpr size_t WS_END2 = WS_PART + (size_t)22 * 128 * DM * 4;
constexpr size_t WS_PCNT = 0x94000;
constexpr size_t WS_SSQ = WS_END2;
constexpr size_t WS_RSTD = WS_SSQ + (size_t)MPAD * 32 * 4;
constexpr size_t WS_END3 = WS_RSTD + (size_t)MPAD * 4;
constexpr int LDS_BYTES = 147456;

typedef __bf16 bf16x2_t __attribute__((ext_vector_type(2)));
typedef float f32x2_t __attribute__((ext_vector_type(2)));
__device__ __forceinline__ unsigned pk(float lo, float hi) { unsigned r; asm volatile("s_nop 1\n\tv_cvt_pk_bf16_f32 %0, %1, %2" : "=v"(r) : "v"(lo), "v"(hi)); return r; }
__device__ __forceinline__ u32x4 pk8(f32x4 a, f32x4 b) { u32x4 w; w.x = pk(a[0], a[1]); w.y = pk(a[2], a[3]); w.z = pk(b[0], b[1]); w.w = pk(b[2], b[3]); return w; }
__device__ __forceinline__ float bflo(unsigned w) { return __uint_as_float(w << 16); }
__device__ __forceinline__ float bfhi(unsigned w) { return __uint_as_float(w & 0xffff0000u); }
__device__ __forceinline__ f32x4 unpk_lo(u32x4 w) { return (f32x4){bflo(w.x), bfhi(w.x), bflo(w.y), bfhi(w.y)}; }
__device__ __forceinline__ f32x4 unpk_hi(u32x4 w) { return (f32x4){bflo(w.z), bfhi(w.z), bflo(w.w), bfhi(w.w)}; }
__device__ __forceinline__ unsigned q8x4(f32x4 g) { const f32x4 v = g * 255.f + 0.5f; return (unsigned)v[0] | ((unsigned)v[1] << 8) | ((unsigned)v[2] << 16) | ((unsigned)v[3] << 24); }
__device__ __forceinline__ f32x4 dq8x4(unsigned w) { return (f32x4){(float)(w & 0xffu), (float)((w >> 8) & 0xffu), (float)((w >> 16) & 0xffu), (float)(w >> 24)} * (1.f / 255.f); }
__device__ __forceinline__ float sigm(float x) { return __builtin_amdgcn_rcpf(1.f + __expf(-x)); }
__device__ __forceinline__ float gelu_t(float x) { const float t = 1.5957691216f * (x + 0.044715f * x * x * x); return x * sigm(t); }
__device__ __forceinline__ f32x4 gelu4(f32x4 v) { return (f32x4){gelu_t(v[0]), gelu_t(v[1]), gelu_t(v[2]), gelu_t(v[3])}; }
__device__ __forceinline__ f32x4 sigm4(f32x4 v) { return (f32x4){sigm(v[0]), sigm(v[1]), sigm(v[2]), sigm(v[3])}; }
__device__ __forceinline__ float sq4(f32x4 v) { return (v[0] * v[0] + v[1] * v[1]) + (v[2] * v[2] + v[3] * v[3]); }
__device__ __forceinline__ float wave_sum(float v) {
#pragma unroll
    for (int o = 1; o < 64; o <<= 1) v += __shfl_xor(v, o);
    return v;
}
__device__ __forceinline__ float wave_max(float v) {
#pragma unroll
    for (int o = 1; o < 64; o <<= 1) v = fmaxf(v, __shfl_xor(v, o));
    return v;
}
#define LDS_WAIT() asm volatile("s_waitcnt lgkmcnt(0)" ::: "memory")
__device__ __forceinline__ float ssv_sum(const float* ssv, size_t row) {
    const f32x4 a = *(const GAS f32x4*)(ssv + row * 16), b = *(const GAS f32x4*)(ssv + row * 16 + 4), c = *(const GAS f32x4*)(ssv + row * 16 + 8), d = *(const GAS f32x4*)(ssv + row * 16 + 12);
    return (((a[0] + a[1]) + (a[2] + a[3])) + ((b[0] + b[1]) + (b[2] + b[3]))) + (((c[0] + c[1]) + (c[2] + c[3])) + ((d[0] + d[1]) + (d[2] + d[3])));
}
__device__ __forceinline__ int otid() { int t = threadIdx.x; asm volatile("" : "+v"(t)); return t; }

__device__ __forceinline__ void st_wt(float* p, float v) { __hip_atomic_store(p, v, __ATOMIC_RELAXED, __HIP_MEMORY_SCOPE_AGENT); }
__device__ __forceinline__ bool arrive_last(unsigned* cnt, unsigned total, bool release) {
    __shared__ unsigned s_last;
    asm volatile("s_waitcnt vmcnt(0)" ::: "memory");
    __syncthreads();
    if (threadIdx.x == 0) {
        if (release) { __builtin_amdgcn_fence(__ATOMIC_RELEASE, "agent"); asm volatile("s_waitcnt vmcnt(0)" ::: "memory"); }
        const unsigned old = __hip_atomic_fetch_add(cnt, 1u, __ATOMIC_RELAXED, __HIP_MEMORY_SCOPE_AGENT);
        s_last = (old + 1u == total) ? 1u : 0u;
    }
    __syncthreads();
    const bool last = s_last != 0u;
    if (last) { __builtin_amdgcn_fence(__ATOMIC_ACQUIRE, "agent"); asm volatile("s_waitcnt vmcnt(0)" ::: "memory"); }
    return last;
}
__device__ __forceinline__ float* keep_ptr(float* out, size_t offp, size_t offs, int layer, int pm, int ai, int row) {
    if (pm < 32) { if ((pm & 7) == 7 && ai == 1) { const int b = pm >> 3, tt = (row & 2047) - 1920; return out + offp + ((size_t)(layer * 4 + b) * 128 + tt) * 256; } return nullptr; }
    if (ai == 0) return out + offs + (size_t)(layer * 128 + (row - TP)) * 256;
    return nullptr;
}
struct EpiIn {
    static constexpr bool PERM = true, AFTER_DRAIN = false, PREFETCH = true;
    __device__ __forceinline__ void pre(float (&e)[8], const Unit& u, int wr, int fr) const {
#pragma unroll
        for (int i = 0; i < 8; ++i) e[i] = rstd[u.pm * 256 + wr * 64 + fr + (i >> 2) * 128 + (i & 3) * 16];
    }
    bf16_t *Q, *Kb, *Vb, *BG, *ZC, *U, *VG, *GT; float* ssv; const float *qn, *kn, *bgate; float* out; int layer; const float* rstd;
    __device__ __forceinline__ void operator()(f32x4 (&acc)[2][2][4][2], const Unit& u, int wr, int wc, int fr, int fq, const float (&epre)[8]) const {
        const int pn = u.pn, pm = u.pm, rb = pm * 256 + wr * 64 + fr;
#pragma unroll
        for (int ai = 0; ai < 2; ++ai)
#pragma unroll
            for (int m = 0; m < 4; ++m) { const float rs_ = epre[ai * 4 + m];
#pragma unroll
                for (int bj = 0; bj < 2; ++bj) { acc[ai][bj][m][0] *= rs_; acc[ai][bj][m][1] *= rs_; } }
        if (pn < 5) {
            const float* nw = pn < 4 ? qn : kn; const float osc = pn < 4 ? 0.125f : 1.f;
            f32x4 w[2][2];
#pragma unroll
            for (int bj = 0; bj < 2; ++bj)
#pragma unroll
                for (int n = 0; n < 2; ++n) w[bj][n] = *(const GAS f32x4*)(nw + 32 * bj + 8 * fq + 4 * n);
#pragma unroll
            for (int ai = 0; ai < 2; ++ai)
#pragma unroll
                for (int m = 0; m < 4; ++m) {
                    const int row = rb + ai * 128 + m * 16;
                    float ss = (sq4(acc[ai][0][m][0]) + sq4(acc[ai][0][m][1])) + (sq4(acc[ai][1][m][0]) + sq4(acc[ai][1][m][1]));
                    ss += __shfl_xor(ss, 16); ss += __shfl_xor(ss, 32);
                    const float rs = rsqrtf(ss * (1.f / 64.f) + EPS);
                    f32x4 o[2][2];
#pragma unroll
                    for (int bj = 0; bj < 2; ++bj)
#pragma unroll
                        for (int n = 0; n < 2; ++n) o[bj][n] = acc[ai][bj][m][n] * rs * w[bj][n];
                    if (pn < 4) { bf16_t* p = Q + (size_t)row * 1024 + (pn * 4 + wc) * 64 + 8 * fq;
#pragma unroll
                        for (int bj = 0; bj < 2; ++bj) *(GAS u32x4*)(p + 32 * bj) = pk8(o[bj][0] * osc, o[bj][1] * osc);
                    } else { bf16_t* p = Kb + (size_t)row * 256 + wc * 64 + 8 * fq;
#pragma unroll
                        for (int bj = 0; bj < 2; ++bj) *(GAS u32x4*)(p + 32 * bj) = pk8(o[bj][0], o[bj][1]);
                        float* dst = keep_ptr(out, O_NKP, O_NKS, layer, pm, ai, row);
                        if (dst) { dst += wc * 64 + 8 * fq;
#pragma unroll
                            for (int bj = 0; bj < 2; ++bj) { *(GAS f32x4*)(dst + 32 * bj) = o[bj][0]; *(GAS f32x4*)(dst + 32 * bj + 4) = o[bj][1]; } }
                    }
                }
        } else if (pn == 5) {
#pragma unroll
            for (int ai = 0; ai < 2; ++ai)
#pragma unroll
                for (int m = 0; m < 4; ++m) {
                    const int row = rb + ai * 128 + m * 16;
                    bf16_t* p = Vb + (size_t)row * 256 + wc * 64 + 8 * fq;
#pragma unroll
                    for (int bj = 0; bj < 2; ++bj) *(GAS u32x4*)(p + 32 * bj) = pk8(acc[ai][bj][m][0], acc[ai][bj][m][1]);
                    float* dst = keep_ptr(out, O_NVP, O_NVS, layer, pm, ai, row);
                    if (dst) { dst += wc * 64 + 8 * fq;
#pragma unroll
                        for (int bj = 0; bj < 2; ++bj) { *(GAS f32x4*)(dst + 32 * bj) = acc[ai][bj][m][0]; *(GAS f32x4*)(dst + 32 * bj + 4) = acc[ai][bj][m][1]; } }
                }
        } else if (pn < 10) {
#pragma unroll
            for (int ai = 0; ai < 2; ++ai)
#pragma unroll
                for (int m = 0; m < 4; ++m) {
                    bf16_t* p = BG + (size_t)(rb + ai * 128 + m * 16) * 1024 + (pn - 6) * 256 + wc * 32 + 8 * fq;
#pragma unroll
                    for (int bj = 0; bj < 2; ++bj) *(GAS u32x4*)(p + 128 * bj) = pk8(acc[ai][bj][m][0], acc[ai][bj][m][1]);
                }
        } else if (pn < 18) {
#pragma unroll
            for (int ai = 0; ai < 2; ++ai)
#pragma unroll
                for (int m = 0; m < 4; ++m) {
                    bf16_t* p = ZC + (size_t)(rb + ai * 128 + m * 16) * 1024 + (pn - 10) * 128 + wc * 32 + 8 * fq;
                    *(GAS u32x4*)p = pk8(acc[ai][0][m][0] * acc[ai][1][m][0], acc[ai][0][m][1] * acc[ai][1][m][1]);
                }
        } else if (pn < 22) {
#pragma unroll
            for (int ai = 0; ai < 2; ++ai)
#pragma unroll
                for (int m = 0; m < 4; ++m) {
                    bf16_t* p = U + (size_t)(rb + ai * 128 + m * 16) * 1024 + (pn - 18) * 256 + wc * 32 + 8 * fq;
#pragma unroll
                    for (int bj = 0; bj < 2; ++bj) *(GAS u32x4*)(p + 128 * bj) = pk8(gelu4(acc[ai][bj][m][0]), gelu4(acc[ai][bj][m][1]));
                }
        } else if (pn < 26) {
#pragma unroll
            for (int ai = 0; ai < 2; ++ai)
#pragma unroll
                for (int m = 0; m < 4; ++m) {
                    const int row = rb + ai * 128 + m * 16;
                    bf16_t* p = VG + (size_t)row * 1024 + (pn - 22) * 256 + wc * 32 + 8 * fq;
                    float ss = 0.f;
#pragma unroll
                    for (int bj = 0; bj < 2; ++bj) { const f32x4 a = gelu4(acc[ai][bj][m][0]), b = gelu4(acc[ai][bj][m][1]); ss += sq4(a) + sq4(b); *(GAS u32x4*)(p + 128 * bj) = pk8(a, b); }
                    ss += __shfl_xor(ss, 16); ss += __shfl_xor(ss, 32);
                    if (fq == 0) ssv[(size_t)row * 16 + (pn - 22) * 4 + wc] = ss;
                }
        } else {
            const int gi = (pn - 26) * 256 + wc * 32 + 8 * fq;
            f32x4 bv[2][2];
#pragma unroll
            for (int bj = 0; bj < 2; ++bj)
#pragma unroll
                for (int n = 0; n < 2; ++n) bv[bj][n] = *(const GAS f32x4*)(bgate + gi + 128 * bj + 4 * n);
#pragma unroll
            for (int ai = 0; ai < 2; ++ai)
#pragma unroll
                for (int m = 0; m < 4; ++m) {
                    unsigned char* p = (unsigned char*)GT + (size_t)(rb + ai * 128 + m * 16) * 6144 + gi;
#pragma unroll
                    for (int bj = 0; bj < 2; ++bj) { u32x2 w; w.x = q8x4(sigm4(acc[ai][bj][m][0] + bv[bj][0])); w.y = q8x4(sigm4(acc[ai][bj][m][1] + bv[bj][1])); *(GAS u32x2*)(p + 128 * bj) = w; }
                }
        }
    }
};
struct EpiBranch {
    static constexpr bool PERM = true, AFTER_DRAIN = false, PREFETCH = false;
    const bf16_t* GT; bf16_t* MG; float* PART; unsigned* cnt;
    __device__ __forceinline__ void operator()(const f32x4 (&acc)[2][2][4][2], const Unit& u, int wr, int wc, int fr, int fq) const { run(acc, u, wr, wc, fr, fq, u.ab); }
    __device__ __forceinline__ void run(const f32x4 (&acc)[2][2][4][2], const Unit& u, int wr, int wc, int fr, int fq, const int bi) const {
        const int rb = u.pm * 256 + wr * 64 + fr, cb = u.pn * 256 + wc * 32 + 8 * fq;
        if (u.part >= 0) {
#pragma unroll
            for (int m = 0; m < 4; ++m) {
                const int r = wr * 64 + m * 16 + fr;
#pragma unroll
                for (int bj = 0; bj < 2; ++bj) {
                    const int col = cb + 128 * bj;
                    const u32x2 g = *(const GAS u32x2*)((const unsigned char*)GT + (size_t)(TP + r) * 6144 + bi * 2048 + col);
                    float* p = PART + ((size_t)(bi * 4 + u.part) * 128 + r) * 2048 + col;
                    *(GAS f32x4*)p = acc[0][bj][m][0] * dq8x4(g.x); *(GAS f32x4*)(p + 4) = acc[0][bj][m][1] * dq8x4(g.y);
                }
            }
            if (arrive_last(cnt + 64 * u.pn, 12u, true)) {
                const int tid = otid();
#pragma unroll 2
                for (int i = 0; i < 16; ++i) {
                    const int idx = tid + 512 * i, r = idx >> 6, col = u.pn * 256 + (idx & 63) * 4;
                    f32x4 s = (f32x4){0.f, 0.f, 0.f, 0.f};
                    f32x4 t[12];
#pragma unroll
                    for (int k = 0; k < 12; ++k) t[k] = *(const GAS f32x4*)(PART + ((size_t)k * 128 + r) * 2048 + col);
#pragma unroll
                    for (int k = 0; k < 12; ++k) s += t[k];
                    u32x2 w; w.x = pk(s[0], s[1]); w.y = pk(s[2], s[3]);
                    *(GAS u32x2*)(MG + (size_t)(TP + r) * 2048 + col) = w;
                }
            }
            return;
        }
#pragma unroll
        for (int ai = 0; ai < 2; ++ai)
#pragma unroll
            for (int m = 0; m < 4; ++m) {
                const size_t row = (size_t)(rb + ai * 128 + m * 16);
#pragma unroll
                for (int bj = 0; bj < 2; ++bj) {
                    const int col = cb + 128 * bj;
                    const u32x2 g = *(const GAS u32x2*)((const unsigned char*)GT + row * 6144 + bi * 2048 + col);
                    f32x4 v0 = acc[ai][bj][m][0] * dq8x4(g.x), v1 = acc[ai][bj][m][1] * dq8x4(g.y);
                    bf16_t* t = MG + row * 2048 + col;
                    if (bi > 0) { const u32x4 o = *(const GAS u32x4*)t; v0 += unpk_lo(o); v1 += unpk_hi(o); }
                    *(GAS u32x4*)t = pk8(v0, v1);
                }
            }
    }
};
__device__ __forceinline__ float rstd_from_ssq(const float* p) {
    float s = 0.f;
#pragma unroll
    for (int i = 0; i < 8; ++i) { const f32x4 v = *(const GAS f32x4*)(p + 4 * i); s += (v[0] + v[1]) + (v[2] + v[3]); }
    return rsqrtf(s * (1.f / DM) + EPS);
}
struct EpiBranch1 {
    static constexpr bool PERM = true, AFTER_DRAIN = false, PREFETCH = false;
    const bf16_t* GT; bf16_t* MG; float* PART; unsigned* cnt; int bi;
    __device__ __forceinline__ void operator()(const f32x4 (&acc)[2][2][4][2], const Unit& u, int wr, int wc, int fr, int fq) const { const EpiBranch E{GT, MG, PART, cnt}; E.run(acc, u, wr, wc, fr, fq, bi); }
};
struct EpiRes {
    static constexpr bool PERM = true, AFTER_DRAIN = false, PREFETCH = false;
    int mode; const float* basef; const float* sbasef; bf16_t* xb; float* dst; int nrows; float* PART; unsigned* cnt; int nsplit; float* ssq; float* rstd; unsigned* pcnt;
    __device__ __forceinline__ void operator()(const f32x4 (&acc)[2][2][4][2], const Unit& u, int wr, int wc, int fr, int fq) const {
        const int rb = u.pm * 256 + wr * 64 + fr, cb = u.pn * 256 + wc * 32 + 8 * fq;
        if (u.part >= 0) {
#pragma unroll
            for (int m = 0; m < 4; ++m) {
                const int r = wr * 64 + m * 16 + fr;
#pragma unroll
                for (int bj = 0; bj < 2; ++bj) {
                    float* p = PART + ((size_t)u.part * 128 + r) * 2048 + cb + 128 * bj;
                    *(GAS f32x4*)p = acc[0][bj][m][0]; *(GAS f32x4*)(p + 4) = acc[0][bj][m][1];
                }
            }
            if (arrive_last(cnt + 64 * u.pn, (unsigned)nsplit, true)) {
                const int tid = otid(), lane = tid & 63;
#pragma unroll 2
                for (int i = 0; i < 16; ++i) {
                    const int idx = tid + 512 * i, r = idx >> 6, col = u.pn * 256 + (idx & 63) * 4;
                    const size_t off = (size_t)(TP + r) * 2048 + col;
                    f32x4 s;
                    if (mode == 0) s = *(const GAS f32x4*)(sbasef + off);
                    else { const u32x2 h = *(const GAS u32x2*)(xb + off); s = (f32x4){bflo(h.x), bfhi(h.x), bflo(h.y), bfhi(h.y)}; }
                    for (int k0 = 0; k0 < nsplit; k0 += 12) {
                        f32x4 t[12];
#pragma unroll
                        for (int j = 0; j < 12; ++j) if (k0 + j < nsplit) t[j] = *(const GAS f32x4*)(PART + ((size_t)(k0 + j) * 128 + r) * 2048 + col);
#pragma unroll
                        for (int j = 0; j < 12; ++j) if (k0 + j < nsplit) s += t[j];
                    }
                    if (mode == 2) *(GAS f32x4*)(dst + off) = s;
                    else {
                        u32x2 w; w.x = pk(s[0], s[1]); w.y = pk(s[2], s[3]); *(GAS u32x2*)(xb + off) = w;
                        const float q = wave_sum(sq4(s));
                        if (lane < 4) st_wt(ssq + (size_t)(TP + r) * 32 + u.pn * 4 + lane, lane == 0 ? q : 0.f);
                    }
                }
                if (mode != 2) { if (arrive_last(pcnt + 64 * 32, 8u, false)) { if (tid < 128) rstd[TP + tid] = rstd_from_ssq(ssq + (size_t)(TP + tid) * 32); } }
            }
            return;
        }
#pragma unroll
        for (int ai = 0; ai < 2; ++ai)
#pragma unroll
            for (int m = 0; m < 4; ++m) {
                const int row = rb + ai * 128 + m * 16;
                if (row < nrows) {
                    float ss = 0.f;
#pragma unroll
                    for (int bj = 0; bj < 2; ++bj) {
                        const size_t off = (size_t)row * 2048 + cb + 128 * bj;
                        f32x4 b0, b1;
                        if (mode == 0) { b0 = *(const GAS f32x4*)(basef + off); b1 = *(const GAS f32x4*)(basef + off + 4); }
                        else { const u32x4 h = *(const GAS u32x4*)(xb + off); b0 = unpk_lo(h); b1 = unpk_hi(h); }
                        const f32x4 x0 = b0 + acc[ai][bj][m][0], x1 = b1 + acc[ai][bj][m][1];
                        if (mode == 2) { *(GAS f32x4*)(dst + off) = x0; *(GAS f32x4*)(dst + off + 4) = x1; }
                        else { *(GAS u32x4*)(xb + off) = pk8(x0, x1); ss += sq4(x0) + sq4(x1); }
                    }
                    if (mode != 2) { ss += __shfl_xor(ss, 16); ss += __shfl_xor(ss, 32); if (fq == 0) st_wt(ssq + (size_t)row * 32 + u.pn * 4 + wc, ss); }
                }
            }
        if (mode != 2) { if (arrive_last(pcnt + 64 * u.pm, 8u, false)) { const int tid = otid(); if (tid < 256) rstd[u.pm * 256 + tid] = rstd_from_ssq(ssq + (size_t)(u.pm * 256 + tid) * 32); } }
    }
};
struct EpiGU {
    static constexpr bool PERM = true, AFTER_DRAIN = false, PREFETCH = true;
    __device__ __forceinline__ void pre(float (&e)[8], const Unit& u, int wr, int fr) const {
#pragma unroll
        for (int i = 0; i < 8; ++i) e[i] = rstd[u.pm * 256 + wr * 64 + fr + (i >> 2) * 128 + (i & 3) * 16];
    }
    bf16_t* H; const float* rstd;
    __device__ __forceinline__ void operator()(f32x4 (&acc)[2][2][4][2], const Unit& u, int wr, int wc, int fr, int fq, const float (&epre)[8]) const {
        const int rb = u.pm * 256 + wr * 64 + fr, cb = u.pn * 128 + wc * 32 + 8 * fq;
#pragma unroll
        for (int ai = 0; ai < 2; ++ai)
#pragma unroll
            for (int m = 0; m < 4; ++m) { const float rs_ = epre[ai * 4 + m];
#pragma unroll
                for (int bj = 0; bj < 2; ++bj) { acc[ai][bj][m][0] *= rs_; acc[ai][bj][m][1] *= rs_; } }
#pragma unroll
        for (int ai = 0; ai < 2; ++ai)
#pragma unroll
            for (int m = 0; m < 4; ++m) {
                const f32x4 g0 = acc[ai][0][m][0], g1 = acc[ai][0][m][1];
                const f32x4 h0 = g0 * sigm4(g0) * acc[ai][1][m][0], h1 = g1 * sigm4(g1) * acc[ai][1][m][1];
                *(GAS u32x4*)(H + (size_t)(rb + ai * 128 + m * 16) * DFF + cb) = pk8(h0, h1);
            }
    }
};

__device__ __forceinline__ int map_in(int n0d) {
    const int pn = n0d >> 8, p = n0d & 255;
    if (pn < 6) { const int bj = p >> 7, wc = (p >> 5) & 3; return pn * 256 + 64 * wc + 32 * bj; }
    if (pn >= 10 && pn < 18) return (p < 128 ? 2560 : 3584) + (pn - 10) * 128 + (p & 127);
    return n0d;
}
__device__ __forceinline__ int map_gu(int n0d) { const int pn = n0d >> 8, p = n0d & 255; return (p < 128 ? 0 : DFF) + pn * 128 + (p & 127); }
constexpr int I_IN = 32 * 400, I_BR = 3 * 16 * 64, I_OUT = 32 * 64, I_GU = 32 * 352, I_DN = 88 * 64, I_LAYER = I_IN + I_BR + I_OUT + I_GU + I_DN;
__device__ __constant__ float CVT_ONES[64] = {1,1,1,1,1,1,1,1,1,1,1,1,1,1,1,1,1,1,1,1,1,1,1,1,1,1,1,1,1,1,1,1,1,1,1,1,1,1,1,1,1,1,1,1,1,1,1,1,1,1,1,1,1,1,1,1,1,1,1,1,1,1,1,1};
struct CvtItem { const float* src; bf16_t* dst; const float* gk; int N, K; };
struct CvtSrc { const float *w_in, *w_br, *w_out, *w_gu, *w_dn; bf16_t* WB; const float *g_mix, *g_ffn; };
__device__ __forceinline__ CvtItem cvt_decode(const CvtSrc& s, int it) {
    const int l = it / I_LAYER; int r = it % I_LAYER;
    bf16_t* wl = s.WB + (size_t)l * WE_LAYER;
    const float* W; const float* gk = nullptr; int N, K, kb, nb, sc;
#define CVT_KN(r_, NB_) do { kb = (r_) / (NB_); nb = (r_) % (NB_); } while (0)
    if (r < I_IN) { CVT_KN(r, 400); W = s.w_in + (size_t)l * DM * INC; N = INC; K = DM; sc = map_in(nb * 32); gk = s.g_mix + l * DM; }
    else if ((r -= I_IN) < I_BR) { const int bi = r / 1024, r2 = r % 1024; CVT_KN(r2, 64); W = s.w_br + (size_t)(l * 3 + bi) * 1024 * 2048; N = 2048; K = 1024; sc = nb * 32; wl += WE_IN + (size_t)bi * 2048 * 1024; }
    else if ((r -= I_BR) < I_OUT) { CVT_KN(r, 64); W = s.w_out + (size_t)l * DM * DM; N = DM; K = DM; sc = nb * 32; wl += WE_IN + WE_BR; }
    else if ((r -= I_OUT) < I_GU) { CVT_KN(r, 352); W = s.w_gu + (size_t)l * DM * 2 * DFF; N = 2 * DFF; K = DM; sc = map_gu(nb * 32); gk = s.g_ffn + l * DM; wl += WE_IN + WE_BR + WE_OUT; }
    else { r -= I_GU; CVT_KN(r, 64); W = s.w_dn + (size_t)l * DFF * DM; N = DM; K = DFF; sc = nb * 32; wl += WE_IN + WE_BR + WE_OUT + WE_GU; }
    CvtItem o; o.src = W + (size_t)(kb * 64) * N + sc; o.dst = wl + (size_t)(nb * 32) * K + kb * 64; o.N = N; o.K = K; o.gk = gk ? gk + kb * 64 : (const float*)CVT_ONES; return o;
}
__device__ __forceinline__ void cvt_load(const CvtItem& it, f32x4 (&v)[8], f32x4 (&g)[2], int lane) {
    g[0] = *(const GAS f32x4*)(it.gk + 8 * (lane & 7)); g[1] = *(const GAS f32x4*)(it.gk + 8 * (lane & 7) + 4);
    const float* src = it.src + (size_t)(lane >> 3) * it.N + 4 * (lane & 7);
#pragma unroll
    for (int i = 0; i < 8; ++i) v[i] = __builtin_nontemporal_load((const GAS f32x4*)(src + (size_t)(8 * i) * it.N));
}
__device__ __forceinline__ void cvt_store(const CvtItem& it, const f32x4 (&v)[8], const f32x4 (&g)[2], LAS float* scr, int lane) {
#pragma unroll
    for (int i = 0; i < 8; ++i) { LAS float* d = scr + (8 * i + (lane >> 3)) * 33 + 4 * (lane & 7); d[0] = v[i][0]; d[1] = v[i][1]; d[2] = v[i][2]; d[3] = v[i][3]; }
    LDS_WAIT();
    const int c = lane & 7;
    const f32x4 g0 = g[0], g1 = g[1];
#pragma unroll
    for (int j = 0; j < 4; ++j) { const int n = (lane >> 3) + 8 * j; const LAS float* s = scr + (8 * c) * 33 + n;
        u32x4 o; o.x = pk(s[0 * 33] * g0[0], s[1 * 33] * g0[1]); o.y = pk(s[2 * 33] * g0[2], s[3 * 33] * g0[3]); o.z = pk(s[4 * 33] * g1[0], s[5 * 33] * g1[1]); o.w = pk(s[6 * 33] * g1[2], s[7 * 33] * g1[3]);
        *(GAS u32x4*)(it.dst + (size_t)n * it.K + 8 * c) = o; }
    LDS_WAIT();
}
__device__ __forceinline__ void convert_weights(const CvtSrc& s, int it_lo, int it_hi, LAS float* scr, int gw, int NGW, int lane) {
    int it = it_lo + gw; if (it >= it_hi) return;
    CvtItem cur = cvt_decode(s, it); f32x4 v[8], gv[2]; cvt_load(cur, v, gv, lane);
    for (;;) {
        const int nit = it + NGW; const bool more = nit < it_hi;
        const CvtItem nxt = cvt_decode(s, more ? nit : it); f32x4 w[8], gw2[2];
        cvt_load(nxt, w, gw2, lane);
        cvt_store(cur, v, gv, scr, lane);
        if (!more) break;
#pragma unroll
        for (int i = 0; i < 8; ++i) v[i] = w[i];
        gv[0] = gw2[0]; gv[1] = gw2[1];
        cur = nxt; it = nit;
    }
}
__device__ __forceinline__ void prep_rows(const float* xp, const float* xs, bf16_t* XN, float* rstd, int gw, int NGW, int lane) {
    for (int r = gw; r < MTOT; r += NGW) {
        const float* src = r < TP ? xp + (size_t)r * DM : xs + (size_t)(r - TP) * DM;
        f32x4 v[8]; float ss = 0.f;
#pragma unroll
        for (int j = 0; j < 8; ++j) { v[j] = ((const GAS f32x4*)src)[lane + 64 * j]; ss += sq4(v[j]); }
        ss = wave_sum(ss);
#pragma unroll
        for (int j = 0; j < 8; ++j) { u32x2 w; w.x = pk(v[j][0], v[j][1]); w.y = pk(v[j][2], v[j][3]); ((GAS u32x2*)(XN + (size_t)r * DM))[lane + 64 * j] = w; }
        if (lane == 0) rstd[r] = rsqrtf(ss * (1.f / DM) + EPS);
    }
}

struct MixP {
    const bf16_t *Q, *Kb, *Vb, *BG, *ZC, *U, *VG; bf16_t *OA, *OB, *OC; const float* ssv;
    const float *ck, *cv, *sc, *sinks, *convw, *vnorm, *wsp, *bsp; float* out; int layer;
};
constexpr int KS_STR = 144, VT_STR = 528, VT_OFF = 256 * KS_STR;
__device__ __forceinline__ void attn_unit(LAS unsigned char* lds, const MixP& P, int b, int n, int kvh) {
    const int tid = otid(), wid = tid >> 6, lane = tid & 63, fr = lane & 15, fq = lane >> 4;
    const int row0 = b * 2048 + (n - 1) * 128;
    const int g = wid >> 1, head = kvh * 4 + g;
    const bf16_t* qp = P.Q + (size_t)(b * 2048 + n * 128 + (wid & 1) * 64 + fr) * 1024 + head * 64 + 8 * fq;
    bf16x8 qn0 = *(const GAS bf16x8*)qp, qn1 = *(const GAS bf16x8*)(qp + 32);
#pragma unroll
    for (int i = 0; i < 4; ++i) {
        const int idx = tid + 512 * i, c = idx >> 3, ch = idx & 7;
        u32x4 kv = (u32x4){0u, 0u, 0u, 0u}, vv = kv;
        if (n > 0 || c >= 128) { kv = *(const GAS u32x4*)(P.Kb + (size_t)(row0 + c) * 256 + kvh * 64 + ch * 8); vv = *(const GAS u32x4*)(P.Vb + (size_t)(row0 + c) * 256 + kvh * 64 + ch * 8); }
        *(LAS u32x4*)(lds + c * KS_STR + ch * 16) = kv;
        LAS unsigned short* vt = (LAS unsigned short*)(lds + VT_OFF + (ch * 8) * VT_STR + c * 2);
        vt[0 * (VT_STR / 2)] = (unsigned short)(vv.x & 0xffff); vt[1 * (VT_STR / 2)] = (unsigned short)(vv.x >> 16);
        vt[2 * (VT_STR / 2)] = (unsigned short)(vv.y & 0xffff); vt[3 * (VT_STR / 2)] = (unsigned short)(vv.y >> 16);
        vt[4 * (VT_STR / 2)] = (unsigned short)(vv.z & 0xffff); vt[5 * (VT_STR / 2)] = (unsigned short)(vv.z >> 16);
        vt[6 * (VT_STR / 2)] = (unsigned short)(vv.w & 0xffff); vt[7 * (VT_STR / 2)] = (unsigned short)(vv.w >> 16);
    }
    __syncthreads();
    const float slope = exp2f(-0.5f * (float)(head + 1)), sink = P.sinks[head];
    const int e0 = fr - 4 * fq;
    float lb[4];
#pragma unroll
    for (int r = 0; r < 4; ++r) lb[r] = -slope * (float)(e0 - r);
#pragma unroll 1
    for (int qt = 0; qt < 4; ++qt) {
        const bf16x8 q0 = qn0, q1 = qn1;
        if (qt < 3) { qn0 = *(const GAS bf16x8*)(qp + (size_t)(qt + 1) * 16 * 1024); qn1 = *(const GAS bf16x8*)(qp + (size_t)(qt + 1) * 16 * 1024 + 32); }
        const int kt0 = (wid & 1) * 4 + qt;
        const size_t qrow = (size_t)(b * 2048 + n * 128 + 16 * kt0 + fr);
        const LAS unsigned char* kb = lds + (16 * kt0 + fr) * KS_STR + 16 * fq;
        f32x4 s[9];
#pragma unroll
        for (int j = 0; j < 9; ++j) {
            const bf16x8 k0 = *(const LAS bf16x8*)(kb + j * 16 * KS_STR), k1 = *(const LAS bf16x8*)(kb + j * 16 * KS_STR + 64);
            f32x4 a = (f32x4){0.f, 0.f, 0.f, 0.f};
            a = __builtin_amdgcn_mfma_f32_16x16x32_bf16(k0, q0, a, 0, 0, 0);
            a = __builtin_amdgcn_mfma_f32_16x16x32_bf16(k1, q1, a, 0, 0, 0);
            s[j] = a;
        }
        float mx = sink;
#pragma unroll
        for (int j = 0; j < 9; ++j) {
            const float tb = -slope * (float)(128 - 16 * j);
            const bool dead = (n == 0) && (kt0 + j < 8);
#pragma unroll
            for (int r = 0; r < 4; ++r) {
                float v = s[j][r] + (tb + lb[r]);
                if (j == 0 && e0 - r >= 0) v = -1e30f;
                if (j == 8 && e0 - r < 0) v = -1e30f;
                if (dead) v = -1e30f;
                s[j][r] = v; mx = fmaxf(mx, v);
            }
        }
        mx = fmaxf(mx, __shfl_xor(mx, 16)); mx = fmaxf(mx, __shfl_xor(mx, 32));
        float sum = 0.f;
#pragma unroll
        for (int j = 0; j < 9; ++j)
#pragma unroll
            for (int r = 0; r < 4; ++r) { const float p = __expf(s[j][r] - mx); s[j][r] = p; sum += p; }
        sum += __shfl_xor(sum, 16); sum += __shfl_xor(sum, 32);
        const float inv = 1.f / (sum + __expf(sink - mx));
        f32x4 o[4];
#pragma unroll
        for (int dt = 0; dt < 4; ++dt) o[dt] = (f32x4){0.f, 0.f, 0.f, 0.f};
        const LAS unsigned char* vbase = lds + VT_OFF + fr * VT_STR + (16 * kt0 + 4 * fq) * 2;
#pragma unroll
        for (int kp = 0; kp < 5; ++kp) {
            const f32x4 z4 = (f32x4){0.f, 0.f, 0.f, 0.f};
            const u32x4 pw = pk8(s[2 * kp], kp < 4 ? s[2 * kp + 1] : z4);
            const bf16x8 pf = __builtin_bit_cast(bf16x8, pw);
#pragma unroll
            for (int dt = 0; dt < 4; ++dt) {
                const LAS unsigned char* vb = vbase + (16 * dt) * VT_STR + 64 * kp;
                const u32x2 v0 = *(const LAS u32x2*)vb, v1 = *(const LAS u32x2*)(vb + (kp < 4 ? 32 : 0));
                const u32x4 vw = (u32x4){v0.x, v0.y, v1.x, v1.y};
                o[dt] = __builtin_amdgcn_mfma_f32_16x16x32_bf16(__builtin_bit_cast(bf16x8, vw), pf, o[dt], 0, 0, 0);
            }
        }
#pragma unroll
        for (int dt = 0; dt < 4; ++dt) { const f32x4 ov = o[dt] * inv; u32x2 w; w.x = pk(ov[0], ov[1]); w.y = pk(ov[2], ov[3]);
            *(GAS u32x2*)(P.OA + qrow * 1024 + head * 64 + 16 * dt + 4 * fq) = w; }
    }
    __syncthreads();
}
constexpr int G_STR = 272, G_WOFF = 128 * G_STR;
__device__ __forceinline__ void gmlp_unit(LAS unsigned char* lds, const MixP& P, int b, int n, int g) {
    const int tid = otid(), wid = tid >> 6, lane = tid & 63, fr = lane & 15, fq = lane >> 4;
    const int row0 = b * 2048 + n * 128;
#pragma unroll
    for (int i = 0; i < 4; ++i) {
        const int idx = tid + 512 * i, q = idx >> 4, ch = idx & 15;
        const u32x4 raw = *(const GAS u32x4*)(P.VG + (size_t)(row0 + q) * 1024 + g * 128 + ch * 8);
        const float rs = rsqrtf(ssv_sum(P.ssv, (size_t)(row0 + q)) * (1.f / 1024.f) + EPS);
        const f32x4 n0 = *(const GAS f32x4*)(P.vnorm + g * 128 + ch * 8), n1 = *(const GAS f32x4*)(P.vnorm + g * 128 + ch * 8 + 4);
        const f32x4 a = unpk_lo(raw) * rs * n0, c = unpk_hi(raw) * rs * n1;
        const u32x4 w = pk8(a, c);
        LAS unsigned short* vt = (LAS unsigned short*)(lds + (ch * 8) * G_STR + q * 2);
        vt[0 * (G_STR / 2)] = (unsigned short)(w.x & 0xffff); vt[1 * (G_STR / 2)] = (unsigned short)(w.x >> 16);
        vt[2 * (G_STR / 2)] = (unsigned short)(w.y & 0xffff); vt[3 * (G_STR / 2)] = (unsigned short)(w.y >> 16);
        vt[4 * (G_STR / 2)] = (unsigned short)(w.z & 0xffff); vt[5 * (G_STR / 2)] = (unsigned short)(w.z >> 16);
        vt[6 * (G_STR / 2)] = (unsigned short)(w.w & 0xffff); vt[7 * (G_STR / 2)] = (unsigned short)(w.w >> 16);
        const int p = idx >> 4, qc = idx & 15;
        const float* wp = P.wsp + (size_t)g * 16384 + p * 128 + qc * 8;
        f32x4 w0 = *(const GAS f32x4*)wp, w1 = *(const GAS f32x4*)(wp + 4);
#pragma unroll
        for (int e = 0; e < 4; ++e) { if (qc * 8 + e > p) w0[e] = 0.f; if (qc * 8 + 4 + e > p) w1[e] = 0.f; }
        *(LAS u32x4*)(lds + G_WOFF + p * G_STR + qc * 16) = pk8(w0, w1);
    }
    __syncthreads();
    bf16x8 af[4];
#pragma unroll
    for (int kk = 0; kk < 4; ++kk) af[kk] = *(const LAS bf16x8*)(lds + (16 * wid + fr) * G_STR + (32 * kk + 8 * fq) * 2);
#pragma unroll
    for (int pt = 0; pt < 8; ++pt) {
        f32x4 d = (f32x4){0.f, 0.f, 0.f, 0.f};
#pragma unroll
        for (int kk = 0; kk < 4; ++kk) if (32 * kk <= 16 * pt + 15) {
            const bf16x8 bf = *(const LAS bf16x8*)(lds + G_WOFF + (16 * pt + fr) * G_STR + (32 * kk + 8 * fq) * 2);
            d = __builtin_amdgcn_mfma_f32_16x16x32_bf16(af[kk], bf, d, 0, 0, 0);
        }
        const size_t off = (size_t)(row0 + 16 * pt + fr) * 1024 + g * 128 + 16 * wid + 4 * fq;
        const float bias = P.bsp[g * 128 + 16 * pt + fr];
        const u32x2 uu = *(const GAS u32x2*)(P.U + off);
        u32x2 w; w.x = pk(bflo(uu.x) * (d[0] + bias), bfhi(uu.x) * (d[1] + bias)); w.y = pk(bflo(uu.y) * (d[2] + bias), bfhi(uu.y) * (d[3] + bias));
        *(GAS u32x2*)(P.OC + off) = w;
    }
    __syncthreads();
}
__device__ __forceinline__ void conv_item(const MixP& P, int row, int ch) {
    const size_t off = (size_t)row * 1024 + ch;
    const u32x4 bgw = *(const GAS u32x4*)(P.BG + off), z0w = *(const GAS u32x4*)(P.ZC + off);
    const f32x4 z0a = unpk_lo(z0w), z0b = unpk_hi(z0w);
    f32x4 z1a, z1b, z2a, z2b;
    if (row < TP) {
        const int t = row & 2047;
        u32x4 z1w = (u32x4){0u, 0u, 0u, 0u}, z2w = z1w;
        if (t >= 1) z1w = *(const GAS u32x4*)(P.ZC + off - 1024);
        if (t >= 2) z2w = *(const GAS u32x4*)(P.ZC + off - 2048);
        z1a = unpk_lo(z1w); z1b = unpk_hi(z1w); z2a = unpk_lo(z2w); z2b = unpk_hi(z2w);
        if (t >= 2046) { float* d = P.out + O_NCP + ((size_t)(P.layer * 4 + (row >> 11)) * 2 + (t - 2046)) * 1024 + ch; *(GAS f32x4*)d = z0a; *(GAS f32x4*)(d + 4) = z0b; }
    } else {
        const int sb = row - TP;
        const float* s = P.sc + (size_t)sb * 2048 + ch;
        z2a = *(const GAS f32x4*)s; z2b = *(const GAS f32x4*)(s + 4); z1a = *(const GAS f32x4*)(s + 1024); z1b = *(const GAS f32x4*)(s + 1028);
        float* d = P.out + O_NCS + ((size_t)(P.layer * 128 + sb) * 2) * 1024 + ch;
        *(GAS f32x4*)d = z1a; *(GAS f32x4*)(d + 4) = z1b; *(GAS f32x4*)(d + 1024) = z0a; *(GAS f32x4*)(d + 1028) = z0b;
    }
    const float* cw = P.convw + ch;
    const f32x4 w0a = *(const GAS f32x4*)cw, w0b = *(const GAS f32x4*)(cw + 4), w1a = *(const GAS f32x4*)(cw + 1024), w1b = *(const GAS f32x4*)(cw + 1028), w2a = *(const GAS f32x4*)(cw + 2048), w2b = *(const GAS f32x4*)(cw + 2052);
    const f32x4 oa = unpk_lo(bgw) * (w0a * z2a + w1a * z1a + w2a * z0a), ob = unpk_hi(bgw) * (w0b * z2b + w1b * z1b + w2b * z0b);
    *(GAS u32x4*)(P.OB + off) = pk8(oa, ob);
}
__device__ __forceinline__ void sgmlp_item(const MixP& P, int sb, int ch) {
    const int g = ch >> 7;
    const size_t row = (size_t)(TP + sb), off = row * 1024 + ch;
    const u32x4 raw = *(const GAS u32x4*)(P.VG + off), uw = *(const GAS u32x4*)(P.U + off);
    const float rs = rsqrtf(ssv_sum(P.ssv, row) * (1.f / 1024.f) + EPS);
    const f32x4 va = unpk_lo(raw) * rs * *(const GAS f32x4*)(P.vnorm + ch), vb = unpk_hi(raw) * rs * *(const GAS f32x4*)(P.vnorm + ch + 4);
    float* d = P.out + O_NGS + (size_t)(P.layer * 128 + sb) * 1024 + ch;
    *(GAS f32x4*)d = va; *(GAS f32x4*)(d + 4) = vb;
    const float w00 = P.wsp[(size_t)g * 16384], b0 = P.bsp[g * 128];
    *(GAS u32x4*)(P.OC + off) = pk8(unpk_lo(uw) * (va * w00 + b0), unpk_hi(uw) * (vb * w00 + b0));
}
__device__ __forceinline__ void sattn_task(LAS float* wl, const MixP& P, int sb, int kvh, int lane) {
    const size_t row = (size_t)(TP + sb);
    LAS float* qs = wl; LAS float* ps = wl + 256;
    { const u32x2 qw = *(const GAS u32x2*)(P.Q + row * 1024 + kvh * 256 + lane * 4);
      *(LAS f32x4*)(qs + lane * 4) = (f32x4){bflo(qw.x), bfhi(qw.x), bflo(qw.y), bfhi(qw.y)}; }
    LDS_WAIT();
    float slope[4], sink[4];
#pragma unroll
    for (int g = 0; g < 4; ++g) { slope[g] = exp2f(-0.5f * (float)(kvh * 4 + g + 1)); sink[g] = P.sinks[kvh * 4 + g]; }
    float s[2][4];
#pragma unroll
    for (int kk = 0; kk < 2; ++kk) {
        const int j = lane + 64 * kk;
        const float* kr = P.ck + ((size_t)(sb * 128 + j) * 4 + kvh) * 64;
        float a[4] = {0.f, 0.f, 0.f, 0.f};
        f32x4 kreg[16];
#pragma unroll
        for (int c = 0; c < 16; ++c) kreg[c] = __builtin_nontemporal_load((const GAS f32x4*)(kr + 4 * c));
#pragma unroll
        for (int c = 0; c < 16; ++c) { const f32x4 kv = kreg[c];
#pragma unroll
            for (int g = 0; g < 4; ++g) { const f32x4 qv = *(const LAS f32x4*)(qs + g * 64 + 4 * c); a[g] += (kv[0] * qv[0] + kv[1] * qv[1]) + (kv[2] * qv[2] + kv[3] * qv[3]); }
            if (c & 1) __builtin_amdgcn_sched_barrier(0); }
#pragma unroll
        for (int g = 0; g < 4; ++g) s[kk][g] = (j >= 1) ? a[g] - slope[g] * (float)(128 - j) : -1e30f;
        asm volatile("" ::: "memory");
    }
    const float kn = bflo((unsigned)P.Kb[row * 256 + kvh * 64 + lane]);
    const float vn = bflo((unsigned)P.Vb[row * 256 + kvh * 64 + lane]);
    float o[4], inv[4];
#pragma unroll
    for (int g = 0; g < 4; ++g) {
        const float sn = wave_sum(kn * qs[g * 64 + lane]);
        float mx = wave_max(fmaxf(s[0][g], s[1][g])); mx = fmaxf(mx, fmaxf(sn, sink[g]));
        const float p0 = __expf(s[0][g] - mx), p1 = __expf(s[1][g] - mx), pn = __expf(sn - mx);
        const float sum = wave_sum(p0 + p1) + pn + __expf(sink[g] - mx);
        inv[g] = 1.f / sum;
        ps[g * 132 + lane] = p0; ps[g * 132 + 64 + lane] = p1;
        o[g] = pn * vn;
    }
    LDS_WAIT();
    const float* vr = P.cv + ((size_t)(sb * 128) * 4 + kvh) * 64 + lane;
#pragma unroll 1
    for (int jb = 0; jb < 4; ++jb) {
        float v[32];
#pragma unroll
        for (int e = 0; e < 32; ++e) v[e] = __builtin_nontemporal_load((const GAS float*)vr + (size_t)(32 * jb + e) * 256);
#pragma unroll
        for (int j4 = 0; j4 < 8; ++j4) {
#pragma unroll
            for (int g = 0; g < 4; ++g) { const f32x4 pp = *(const LAS f32x4*)(ps + g * 132 + 32 * jb + 4 * j4); o[g] += (pp[0] * v[4 * j4] + pp[1] * v[4 * j4 + 1]) + (pp[2] * v[4 * j4 + 2] + pp[3] * v[4 * j4 + 3]); }
            if (j4 & 1) __builtin_amdgcn_sched_barrier(0);
        }
    }
#pragma unroll
    for (int g = 0; g < 4; ++g) P.OA[row * 1024 + (kvh * 4 + g) * 64 + lane] = (bf16_t)(pk(o[g] * inv[g], 0.f) & 0xffff);
    LDS_WAIT();
}
constexpr int MU_ATT = 256, MU_GM = MU_ATT + 512;
#ifndef PROBE_MIX
#define PROBE_MIX 0
#endif
__device__ __forceinline__ void mixers_phase(LAS unsigned char* lds, const MixP& P) {
    for (int u = blockIdx.x; u < MU_GM; u += gridDim.x) {
        if (u < MU_ATT) { attn_unit(lds, P, u >> 6, (u >> 2) & 15, u & 3); if (PROBE_MIX & 1) attn_unit(lds, P, u >> 6, (u >> 2) & 15, u & 3); }
        else { const int v = u - MU_ATT; gmlp_unit(lds, P, v >> 7, (v >> 3) & 15, v & 7); if (PROBE_MIX & 2) gmlp_unit(lds, P, v >> 7, (v >> 3) & 15, v & 7); }
    }
    const int tid = otid(), wid = tid >> 6, lane = tid & 63;
    if (wid < 2) {
        for (int id = blockIdx.x * 2 + wid; id < 512; id += gridDim.x * 2) sattn_task((LAS float*)(lds + wid * 4096), P, id >> 2, id & 3, lane);
    } else {
        const int t6 = tid - 128, stride = gridDim.x * 384;
        for (int it = blockIdx.x * 384 + t6; it < MTOT * 128; it += stride) conv_item(P, it >> 7, (it & 127) * 8);
        for (int it = blockIdx.x * 384 + t6; it < 128 * 128; it += stride) sgmlp_item(P, it >> 7, (it & 127) * 8);
    }
}

#define XB_TMO      128
#define XB_XCNT(j)  (256  + 64 * (j))
#define XB_XSUB(j)  (1280 + 64 * (j))
#define XB_XGEN(j)  (2304 + 64 * (j))
#define XB_TOP      3328
#define XB_TOPGEN   3392
#define XCD_BAR_WORDS 3456
#define XB_SPIN_CAP (1u << 18)

__device__ __forceinline__ unsigned xb_ld(unsigned* p)              { return __hip_atomic_load(p, __ATOMIC_RELAXED, __HIP_MEMORY_SCOPE_AGENT); }
__device__ __forceinline__ unsigned xb_add(unsigned* p, unsigned v) { return __hip_atomic_fetch_add(p, v, __ATOMIC_RELAXED, __HIP_MEMORY_SCOPE_AGENT); }
__device__ __forceinline__ unsigned xb_xcc_id() { return (unsigned)__builtin_amdgcn_s_getreg((3 << 11) | 20) & 0xFu; }
#define XB_SPIN(cond, bar) do { unsigned _sp = 0; while (cond) { __builtin_amdgcn_s_sleep(1); \
    if ((++_sp & 255u) == 0u) { if (xb_ld(&(bar)[XB_TMO])) break; if (_sp > XB_SPIN_CAP) { atomicAdd(&(bar)[XB_TMO], 1u); break; } } } } while (0)

struct XcdBarrier {
    unsigned* bar; unsigned x;
    volatile LAS unsigned* st;
};

__device__ __forceinline__ XcdBarrier xcd_barrier_post(unsigned* bar, volatile LAS unsigned* st) {
    XcdBarrier b; b.bar = bar; b.x = xb_xcc_id(); b.st = st;
    if (threadIdx.x == 0) (void)xb_add(&bar[XB_XCNT(b.x)], 1u);
    return b;
}
__device__ __forceinline__ void xcd_barrier_complete(unsigned* bar, unsigned x, unsigned& nloc, unsigned& nx) {
    const unsigned G = gridDim.x * gridDim.y * gridDim.z;
    unsigned sum, cnt, mine, sp = 0u;
    for (;;) {
        sum = 0u; cnt = 0u; mine = 0u;
#pragma unroll
        for (unsigned j = 0; j < 16; ++j) { const unsigned c = xb_ld(&bar[XB_XCNT(j)]); sum += c; cnt += (c > 0u) ? 1u : 0u; mine = (j == x) ? c : mine; }
        if (sum == G) break;
        __builtin_amdgcn_s_sleep(1);
        if ((++sp & 255u) == 0u) { if (xb_ld(&bar[XB_TMO])) break; if (sp > XB_SPIN_CAP) { atomicAdd(&bar[XB_TMO], 1u); break; } }
    }
    nloc = mine > 0u ? mine : 1u; nx = cnt > 0u ? cnt : 1u;
}

__device__ __forceinline__ void xcd_barrier(const XcdBarrier& b) {
    asm volatile("s_waitcnt vmcnt(0)" ::: "memory");
    __syncthreads();
    if (threadIdx.x == 0) {
        unsigned* bar = b.bar;
        __builtin_amdgcn_s_waitcnt(0);
        unsigned nloc = b.st[0], nx = b.st[1];
        if (nloc == 0u) { xcd_barrier_complete(bar, b.x, nloc, nx); b.st[0] = nloc; b.st[1] = nx; }
        const unsigned old = xb_add(&bar[XB_XSUB(b.x)], 1u);
        const unsigned gen = old / nloc;
        if (old + 1u == (gen + 1u) * nloc) {
            __builtin_amdgcn_fence(__ATOMIC_RELEASE, "agent");
            asm volatile("s_waitcnt vmcnt(0)" ::: "memory");
            const unsigned og = xb_add(&bar[XB_TOP], 1u);
            const unsigned tg = og / nx;
            if (og + 1u == (tg + 1u) * nx) xb_add(&bar[XB_TOPGEN], 1u);
            else XB_SPIN(xb_ld(&bar[XB_TOPGEN]) == tg, bar);
            __builtin_amdgcn_fence(__ATOMIC_ACQUIRE, "agent");
            xb_add(&bar[XB_XGEN(b.x)], 1u);
            asm volatile("s_waitcnt vmcnt(0)" ::: "memory");
        } else {
            XB_SPIN(xb_ld(&bar[XB_XGEN(b.x)]) == gen, bar);
            __builtin_amdgcn_fence(__ATOMIC_ACQUIRE, "agent");
            asm volatile("s_waitcnt vmcnt(0)" ::: "memory");
        }
    }
    __syncthreads();
}

struct Args { const float* in[20]; float* out; unsigned char* ws; };
constexpr int BUBBLE_ITEMS = 96, BUB_A_BLK0 = 1650 % 256, BUB_B_BLK0 = 1452 % 256;
constexpr int BUB_B_N = (256 - BUB_B_BLK0) * BUBBLE_ITEMS;
constexpr int POOL_LO = I_IN, POOL_HI = 2 * I_LAYER - BUB_B_N, POOL_N7 = 146, POOL_N6 = 226;
static_assert(BUB_A_BLK0 * POOL_N7 + (256 - BUB_A_BLK0) * POOL_N6 <= POOL_HI - POOL_LO && POOL_HI - POOL_LO - (BUB_A_BLK0 * POOL_N7 + (256 - BUB_A_BLK0) * POOL_N6) < 64 && BUB_B_N % 8 == 0, "conversion pool split");
#define PH_BEGIN \
    const int tid = otid(), lane = tid & 63, wid = __builtin_amdgcn_readfirstlane(tid >> 6), gw = blockIdx.x * 8 + wid; (void)lane; (void)gw; \
    const int G = gridDim.x, NGW = G * 8; (void)NGW; \
    unsigned char* ws = a.ws; asm volatile("" : "+s"(ws)); \
    const bf16_t* wl = (const bf16_t*)(ws + WS_W) + (size_t)L * WE_LAYER; (void)wl;
#define WSP(T, off) ((T*)(ws + (off)))
template <int L> __device__ __forceinline__ void run_layer(const Args& a, LAS unsigned char* lds, const XcdBarrier& bar) {
    {
        PH_BEGIN
        pg8::Gemm g{WSP(bf16_t, WS_XN), wl, MPAD, INC, DM, 0, 0}; pg8::StaticOrder S; S.init(MPAD, INC, DM, G, (int)blockIdx.x);
        EpiIn E{WSP(bf16_t, WS_Q), WSP(bf16_t, WS_K), WSP(bf16_t, WS_V), WSP(bf16_t, WS_BG), WSP(bf16_t, WS_ZC), WSP(bf16_t, WS_U), WSP(bf16_t, WS_VG), WSP(bf16_t, WS_GT), WSP(float, WS_SSV),
                a.in[8] + L * 64, a.in[9] + L * 64, a.in[7] + L * 6144, a.out, L, WSP(float, WS_RSTD)};
        const int bx = (int)blockIdx.x;
        const bool pool = (L == 0 && G == 256);
        const int plo = POOL_LO + (bx < BUB_A_BLK0 ? bx * POOL_N7 : BUB_A_BLK0 * POOL_N7 + (bx - BUB_A_BLK0) * POOL_N6);
        const int phi = bx == 255 ? POOL_HI : plo + (bx < BUB_A_BLK0 ? POOL_N7 : POOL_N6);
        const CvtSrc cs{a.in[6], a.in[15], a.in[16], a.in[18], a.in[19], WSP(bf16_t, WS_W), a.in[5], a.in[17]};
        if (pool && !(bx & 1)) { convert_weights(cs, plo, phi, (LAS float*)(lds + wid * 16384), wid, 8, lane); __syncthreads(); }
        pg8::gemm_phase<EpiIn, pg8::StaticOrder, true, true>(lds, g, S, E);
        if (pool && (bx & 1)) convert_weights(cs, plo, phi, (LAS float*)(lds + wid * 16384), wid, 8, lane);
    }
    xcd_barrier(bar);
    {
        PH_BEGIN
        MixP P{WSP(bf16_t, WS_Q), WSP(bf16_t, WS_K), WSP(bf16_t, WS_V), WSP(bf16_t, WS_BG), WSP(bf16_t, WS_ZC), WSP(bf16_t, WS_U), WSP(bf16_t, WS_VG), WSP(bf16_t, WS_OA), WSP(bf16_t, WS_OB), WSP(bf16_t, WS_OC), WSP(float, WS_SSV),
               a.in[2] + (size_t)L * 128 * 128 * 256, a.in[3] + (size_t)L * 128 * 128 * 256, a.in[4] + (size_t)L * 128 * 2048, a.in[10] + L * 16, a.in[11] + L * 3072, a.in[12] + L * 1024,
               a.in[13] + (size_t)L * 8 * 16384, a.in[14] + L * 1024, a.out, L};
        mixers_phase(lds, P);
    }
    xcd_barrier(bar);
    {
        PH_BEGIN
        if (G == 256) {
            pg8::Gemm g{WSP(bf16_t, WS_OA), wl + WE_IN, MPAD, DM, 1024, (size_t)MPAD * 1024 * 2, (size_t)2048 * 1024 * 2}; pg8::BranchOrder S; S.init(DM, 1024, G, (int)blockIdx.x);
            EpiBranch E{WSP(bf16_t, WS_GT), WSP(bf16_t, WS_MG), WSP(float, WS_PART), WSP(unsigned, WS_CNT) + (L * 3 + 0) * 512};
            pg8::gemm_phase<EpiBranch, pg8::BranchOrder, true, true>(lds, g, S, E);
        } else {
            for (int bi = 0; bi < 3; ++bi) {
                pg8::Gemm g{WSP(bf16_t, WS_OA) + (size_t)bi * MPAD * 1024, wl + WE_IN + (size_t)bi * 2048 * 1024, MPAD, DM, 1024, 0, 0}; pg8::TailOrder S; S.init(TP, DM, 1024, G, (int)blockIdx.x);
                EpiBranch1 E{WSP(bf16_t, WS_GT), WSP(bf16_t, WS_MG), WSP(float, WS_PART), WSP(unsigned, WS_CNT) + (L * 3 + 0) * 512, bi};
                pg8::gemm_phase<EpiBranch1, pg8::TailOrder, true, true>(lds, g, S, E);
            }
        }
    }
    xcd_barrier(bar);
    {
        PH_BEGIN
        pg8::Gemm g{WSP(bf16_t, WS_MG), wl + WE_IN + WE_BR, MPAD, DM, DM, 0, 0}; pg8::TailOrder S; S.init(TP, DM, DM, G, (int)blockIdx.x);
        EpiRes E{1, a.in[0], a.in[1] - (size_t)TP * DM, WSP(bf16_t, WS_XN), nullptr, MPAD, WSP(float, WS_PART), WSP(unsigned, WS_CNT) + (L * 3 + 1) * 512, DM / 256,
                 WSP(float, WS_SSQ), WSP(float, WS_RSTD), WSP(unsigned, WS_PCNT) + (L * 2 + 0) * 40 * 64};
        pg8::gemm_phase<EpiRes, pg8::TailOrder, true, true>(lds, g, S, E);
    }
    xcd_barrier(bar);
    {
        PH_BEGIN
        pg8::Gemm g{WSP(bf16_t, WS_XN), wl + WE_IN + WE_BR + WE_OUT, MPAD, 2 * DFF, DM, 0, 0}; pg8::StaticOrder S; S.init(MPAD, 2 * DFF, DM, G, (int)blockIdx.x);
        EpiGU E{WSP(bf16_t, WS_H), WSP(float, WS_RSTD)};
        pg8::gemm_phase<EpiGU, pg8::StaticOrder, true, true>(lds, g, S, E);
        if (L == 0 && G == 256 && (int)blockIdx.x >= BUB_B_BLK0) {
            const CvtSrc cs{a.in[6], a.in[15], a.in[16], a.in[18], a.in[19], WSP(bf16_t, WS_W), a.in[5], a.in[17]};
            convert_weights(cs, POOL_HI, 2 * I_LAYER, (LAS float*)(lds + wid * 16384), ((int)blockIdx.x - BUB_B_BLK0) * 8 + wid, (256 - BUB_B_BLK0) * 8, lane);
        }
    }
    xcd_barrier(bar);
    {
        PH_BEGIN
        pg8::Gemm g{WSP(bf16_t, WS_H), wl + WE_IN + WE_BR + WE_OUT + WE_GU, MPAD, DM, DFF, 0, 0}; pg8::TailOrder S; S.init(TP, DM, DFF, G, (int)blockIdx.x);
        EpiRes E{L == 1 ? 2 : 1, nullptr, nullptr, WSP(bf16_t, WS_XN), a.out, L == 1 ? MTOT : MPAD, WSP(float, WS_PART), WSP(unsigned, WS_CNT) + (L * 3 + 2) * 512, DFF / 256,
                 WSP(float, WS_SSQ), WSP(float, WS_RSTD), WSP(unsigned, WS_PCNT) + (L * 2 + 1) * 40 * 64};
        pg8::gemm_phase<EpiRes, pg8::TailOrder, true, true>(lds, g, S, E);
    }
}
#ifndef PROBE_SYNCS
#define PROBE_SYNCS 0
#endif
__global__ void __launch_bounds__(512, 2) hybrid_fwd(Args a) {
    extern __shared__ __attribute__((aligned(16))) unsigned char lds_raw[];
    LAS unsigned char* lds = (LAS unsigned char*)lds_raw;
    cg::grid_group grid = cg::this_grid();
    volatile LAS unsigned* bst = (volatile LAS unsigned*)(lds + 131072 + 64);
    if (threadIdx.x < 2) bst[threadIdx.x] = 0u;
    __syncthreads();
    const XcdBarrier bar = xcd_barrier_post((unsigned*)(a.ws + WS_BAR), bst);
    grid.sync();
    {
        constexpr int L = 0;
        PH_BEGIN
        { const CvtSrc cs{a.in[6], a.in[15], a.in[16], a.in[18], a.in[19], WSP(bf16_t, WS_W), a.in[5], a.in[17]}; convert_weights(cs, 0, G == 256 ? I_IN : 2 * I_LAYER, (LAS float*)(lds + wid * 16384), gw, NGW, lane); }
        prep_rows(a.in[0], a.in[1], WSP(bf16_t, WS_XN), WSP(float, WS_RSTD), gw, NGW, lane);
    }
    xcd_barrier(bar);
    run_layer<0>(a, lds, bar);
    xcd_barrier(bar);
    run_layer<1>(a, lds, bar);
    for (int i = 0; i < PROBE_SYNCS; ++i) xcd_barrier(bar);
}

extern "C" void kernel_launch(void* const* d_in, const int* in_sizes, int n_in, void* d_out, int out_size, void* d_ws, size_t ws_size, hipStream_t stream) {
    static int grid = 0;
    if (grid == 0) {
        if (n_in != 20 || ws_size < WS_END3) { fprintf(stderr, "kernel_launch: need 20 inputs and %zu bytes of workspace, got %d / %zu\n", (size_t)WS_END3, n_in, ws_size); grid = -1; return; }
        int dev = 0, cus = 0, per_cu = 0;
        if (hipGetDevice(&dev) != hipSuccess || hipDeviceGetAttribute(&cus, hipDeviceAttributeMultiprocessorCount, dev) != hipSuccess) { grid = -1; return; }
        if (hipFuncSetAttribute((const void*)hybrid_fwd, hipFuncAttributeMaxDynamicSharedMemorySize, LDS_BYTES) != hipSuccess) { fprintf(stderr, "kernel_launch: hipFuncSetAttribute failed\n"); grid = -1; return; }
        if (hipOccupancyMaxActiveBlocksPerMultiprocessor(&per_cu, (const void*)hybrid_fwd, 512, LDS_BYTES) != hipSuccess || per_cu < 1) { fprintf(stderr, "kernel_launch: occupancy query says %d\n", per_cu); per_cu = 1; }
        (void)hipGetLastError();
        grid = cus * (per_cu > 1 ? 1 : per_cu);
    }
    if (grid < 0) return;
    if (hipMemsetAsync((char*)d_ws + WS_ZERO_LO, 0, WS_ZERO_BYTES, stream) != hipSuccess) { fprintf(stderr, "kernel_launch: memset failed\n"); return; }
    Args a{};
    for (int i = 0; i < 20; ++i) a.in[i] = (const float*)d_in[i];
    a.out = (float*)d_out; a.ws = (unsigned char*)d_ws;
    void* args[] = {&a};
    hipError_t e = hipLaunchCooperativeKernel((const void*)hybrid_fwd, dim3(grid), dim3(512), args, LDS_BYTES, stream);
    if (e != hipSuccess) fprintf(stderr, "cooperative launch failed: %s (grid %d)\n", hipGetErrorString(e), grid);
}
```

```cpp
#include <hip/hip_runtime.h>
#include <hip/hip_cooperative_groups.h>
#include <cstdio>
#include <cstdint>
namespace cg = cooperative_groups;
namespace pg8 {
#define PG8_LAS __attribute__((address_space(3)))
typedef unsigned short bf16_t;
typedef short bf16x8 __attribute__((ext_vector_type(8)));
typedef float f32x4 __attribute__((ext_vector_type(4)));
typedef unsigned u32x4 __attribute__((ext_vector_type(4)));
constexpr int BM = 256, BK = 64, HALF = 128, HTB = HALF * BK * 2  , STAGE_BYTES = 8 * HTB, NXCD = 8, WGM = 8;

__host__ __device__ __forceinline__ int lds_byte(int r, int c) { const int st = (r >> 4) * 2 + (c >> 5), rr = r & 15, cc = c & 31, ob = rr * 64 + cc * 2; return st * 1024 + (ob ^ (((ob >> 9) & 1) << 5)); }
__host__ __device__ __forceinline__ void stage_rc(int b, int& R, int& C) { const int st = b / 1024, sb = b % 1024, swz = sb ^ (((sb >> 9) & 1) << 5); R = (st >> 1) * 16 + swz / 64; C = (st & 1) * 32 + (swz % 64) / 2; }
__host__ __device__ __forceinline__ int perm32(int rho) { const int n = rho >> 4, i = rho & 15; return 8 * (i >> 2) + 4 * n + (i & 3); }

struct Unit { int pm, pn, k0, nt, part, ab; };
struct Gemm { const bf16_t* A; const bf16_t* Bt; int M, N, K; size_t sA, sB; };

struct StaticOrder {
    int nM, nN, nwg, G, c, ntk;
    __host__ __device__ __forceinline__ void init(int M, int N, int K, int G_, int c_) { nM = M / BM; nN = N / BM; nwg = nM * nN; G = G_; c = c_; ntk = K / BK; }
    __host__ __device__ __forceinline__ bool next(int i, Unit& u) const {
        const long L = (long)i * G + c; if (L >= nwg) return false;
        u.k0 = 0; u.nt = ntk; u.part = -1; u.ab = 0;
        int wgid = (int)L; { const int q = nwg / NXCD, r = nwg % NXCD, xcd = wgid % NXCD, off = wgid / NXCD; wgid = (xcd < r ? xcd * (q + 1) : r * (q + 1) + (xcd - r) * q) + off; }
        const int nig = WGM * nN, gid = wgid / nig, fm = gid * WGM, gsz = (nM - fm) < WGM ? (nM - fm) : WGM;
        u.pm = fm + ((wgid % nig) % gsz); u.pn = (wgid % nig) / gsz; return true;
    }
    __device__ __forceinline__ void a_ready(const Unit&) const {}
    __device__ __forceinline__ void done(const Unit&) const {}
};

struct TailOrder {
    int nM, nN, nfull, nmini, G, c, ntk;
    __host__ __device__ __forceinline__ void init(int Mfull, int N, int K, int G_, int c_) { nM = Mfull / BM; nN = N / BM; nfull = nM * nN; nmini = nN * (K / 256); G = G_; c = c_; ntk = K / BK; }
    __host__ __device__ __forceinline__ bool next(int i, Unit& u) const {
        const int L = i * G + c;
        const bool full = L < nfull, ok = L < nfull + nmini;
        int wgid = full ? L : 0; { const int q = nfull / NXCD, r = nfull % NXCD, xcd = wgid % NXCD, off = wgid / NXCD; wgid = (xcd < r ? xcd * (q + 1) : r * (q + 1) + (xcd - r) * q) + off; }
        const int nig = WGM * nN, gid = wgid / nig, fm = gid * WGM, gsz = (nM - fm) < WGM ? (nM - fm) : WGM;
        const int fpm = fm + ((wgid % nig) % gsz), fpn = (wgid % nig) / gsz;
        const int j = L - nfull, mpn = j % nN, mks = j / nN;
        Unit r_; r_.pm = full ? fpm : nM; r_.pn = full ? fpn : mpn; r_.k0 = full ? 0 : mks * 256; r_.nt = full ? ntk : 4; r_.part = full ? -1 : mks; r_.ab = 0;
        u = r_; return ok;
    }
    __device__ __forceinline__ void a_ready(const Unit&) const {}
    __device__ __forceinline__ void done(const Unit&) const {}
};
struct BranchOrder {
    int nN, G, c, ntk;
    __host__ __device__ __forceinline__ void init(int N, int K, int G_, int c_) { nN = N / BM; G = G_; c = c_; ntk = K / BK; }
    __host__ __device__ __forceinline__ bool next(int i, Unit& u) const {
        const bool full = i < 3, ok = full || (i == 3 && c < 96);
        int wgid = c; { const int nfull = 256, q = nfull / NXCD, xcd = wgid % NXCD, off = wgid / NXCD; wgid = xcd * q + off; }
        const int nig = WGM * nN, gid = wgid / nig, fm = gid * WGM;
        const int fpm = fm + ((wgid % nig) % WGM), fpn = (wgid % nig) / WGM;
        const int jj = c & 31, mpn = jj % nN, mks = jj / nN;
        Unit r_; r_.pm = full ? fpm : 32; r_.pn = full ? fpn : mpn; r_.k0 = full ? 0 : mks * 256; r_.nt = full ? ntk : 4; r_.part = full ? -1 : mks; r_.ab = full ? i : (c >> 5);
        u = r_; return ok;
    }
    __device__ __forceinline__ void a_ready(const Unit&) const {}
    __device__ __forceinline__ void done(const Unit&) const {}
};
__device__ __forceinline__ unsigned cvt_pk_bf16(float lo, float hi) { unsigned r; asm volatile("v_cvt_pk_bf16_f32 %0, %1, %2" : "=v"(r) : "v"(lo), "v"(hi)); return r; }
typedef float f32x2 __attribute__((ext_vector_type(2)));
template <class Epi, class Sched, bool ALIGN_EPI = false, bool SP2 = false>
__device__ __forceinline__ void gemm_phase(PG8_LAS unsigned char* lds, const Gemm g, const Sched& S, const Epi& E) {
    int tid0_ = threadIdx.x; asm volatile("" : "+v"(tid0_)); const int tid = tid0_, wid = __builtin_amdgcn_readfirstlane(tid >> 6), lane = tid & 63, wr = wid >> 2, wc = wid & 3, fr = lane & 15, fq = lane >> 4;
    const int K = g.K;
    unsigned voffA[2], voffB[2];
#pragma unroll
    for (int i = 0; i < 2; ++i) { int R, C; stage_rc(tid * 16 + i * 8192, R, C); const int Rb = Epi::PERM ? ((R & ~31) + perm32(R & 31)) : R;
        voffA[i] = (unsigned)(R * K + C) * 2u; voffB[i] = (unsigned)(Rb * K + C) * 2u; }
    const size_t kstep = (size_t)(BK * 2);
    const size_t hstep = (size_t)HALF * K * 2;
    const size_t tstep = 2 * hstep;
    const unsigned ldsw = (unsigned)wid * 1024u;
    const int aoff = lds_byte(wr * 64 + fr, fq * 8), boff = lds_byte(wc * 32 + fr, fq * 8);
#define PG8_SA(b, h) (((b) * 2 + (h)) * HTB)
#define PG8_SB(b, h) ((4 + (b) * 2 + (h)) * HTB)
#define PG8_STAGE(bufoff, gbase, voff) do { _Pragma("unroll") for (int _i = 0; _i < 2; ++_i) \
        __builtin_amdgcn_global_load_lds((const unsigned*)((const char*)(gbase) + (voff)[_i]), (PG8_LAS unsigned*)(lds + (bufoff) + ldsw + _i * 8192), 16, 0, 0); } while (0)
#define PG8_LDA(dst, b, h) do { _Pragma("unroll") for (int m = 0; m < 4; ++m) _Pragma("unroll") for (int k = 0; k < 2; ++k) dst[m][k] = *(const PG8_LAS bf16x8*)(lds + PG8_SA(b, h) + aoff + m * 2048 + k * 1024); } while (0)
#define PG8_LDB(dst, b, h) do { _Pragma("unroll") for (int n = 0; n < 2; ++n) _Pragma("unroll") for (int k = 0; k < 2; ++k) dst[n][k] = *(const PG8_LAS bf16x8*)(lds + PG8_SB(b, h) + boff + n * 2048 + k * 1024); } while (0)
#define PG8_MMA(ai, bj, At, Bt) do { __builtin_amdgcn_s_setprio(1); _Pragma("unroll") for (int m = 0; m < 4; ++m) _Pragma("unroll") for (int n = 0; n < 2; ++n) _Pragma("unroll") for (int k = 0; k < 2; ++k) \
        acc[ai][bj][m][n] = __builtin_amdgcn_mfma_f32_16x16x32_bf16(Bt[n][k], At[m][k], acc[ai][bj][m][n], 0, 0, 0); __builtin_amdgcn_s_setprio(0); } while (0)
#define PG8_WAIT_V(n) asm volatile("s_waitcnt vmcnt(" #n ")" ::: "memory")
#define PG8_WAIT_L(n) asm volatile("s_waitcnt lgkmcnt(" #n ")" ::: "memory")
#define PG8_BAR __builtin_amdgcn_s_barrier()
#define PG8_SCHED __builtin_amdgcn_sched_barrier(0)
    Unit cur, nxt; int ui = 0;
    if (!S.next(0, cur)) return;
    f32x4 acc[2][2][4][2];
    float epre[8];
#pragma unroll
    for (int i_ = 0; i_ < 8; ++i_) epre[i_] = 0.f;
#pragma unroll
    for (int a = 0; a < 2; ++a)
#pragma unroll
        for (int b = 0; b < 2; ++b)
#pragma unroll
            for (int m = 0; m < 4; ++m)
#pragma unroll
                for (int n = 0; n < 2; ++n) acc[a][b][m][n] = (f32x4){0.f, 0.f, 0.f, 0.f};
    bf16x8 At[4][2], B0[2][2], B1[2][2];
    const char* cA = (const char*)g.A + (size_t)cur.ab * g.sA + (size_t)cur.pm * tstep + (size_t)cur.k0 * 2; const char* cB = (const char*)g.Bt + (size_t)cur.ab * g.sB + (size_t)cur.pn * tstep + (size_t)cur.k0 * 2;
    S.a_ready(cur);
    if constexpr (SP2) {
        PG8_STAGE(PG8_SB(0, 0), cB, voffB); PG8_STAGE(PG8_SB(0, 1), cB + hstep, voffB); PG8_STAGE(PG8_SA(0, 0), cA, voffA); PG8_STAGE(PG8_SA(0, 1), cA + hstep, voffA);
        if (wr == 1) PG8_BAR;
        PG8_WAIT_V(2); PG8_BAR;
        PG8_STAGE(PG8_SB(1, 0), cB + kstep, voffB); PG8_STAGE(PG8_SA(1, 0), cA + kstep, voffA); PG8_STAGE(PG8_SB(1, 1), cB + hstep + kstep, voffB);
        PG8_WAIT_V(6); PG8_BAR;
    } else {
        PG8_STAGE(PG8_SB(0, 0), cB, voffB); PG8_STAGE(PG8_SA(0, 0), cA, voffA); PG8_STAGE(PG8_SB(0, 1), cB + hstep, voffB); PG8_STAGE(PG8_SA(0, 1), cA + hstep, voffA);
        if (wr == 1) PG8_BAR;
        PG8_WAIT_V(4); PG8_BAR;
        PG8_STAGE(PG8_SB(1, 0), cB + kstep, voffB); PG8_STAGE(PG8_SA(1, 0), cA + kstep, voffA); PG8_STAGE(PG8_SB(1, 1), cB + hstep + kstep, voffB);
        PG8_WAIT_V(6); PG8_BAR;
    }
    for (;;) {
        const bool has_next = S.next(ui + 1, nxt);
        const char* nA = has_next ? (const char*)g.A + (size_t)nxt.ab * g.sA + (size_t)nxt.pm * tstep + (size_t)nxt.k0 * 2 : cA; const char* nB = has_next ? (const char*)g.Bt + (size_t)nxt.ab * g.sB + (size_t)nxt.pn * tstep + (size_t)nxt.k0 * 2 : cB;
        const int nt = cur.nt;
        for (int t = 0; t < nt; t += 2) {
            const bool last = (t == nt - 2);
            const char* a1 = cA + (size_t)(t + 1) * kstep;
            const char* a2 = last ? nA : cA + (size_t)(t + 2) * kstep; const char* b2 = last ? nB : cB + (size_t)(t + 2) * kstep;
            const char* a3 = a2 + kstep; const char* b3 = b2 + kstep;
            if (last && has_next) S.a_ready(nxt);
            if constexpr (Epi::PREFETCH) { if (last) E.pre(epre, cur, wr, fr); }
            if constexpr (SP2) {
            PG8_LDB(B0, 0, 0); PG8_LDB(B1, 0, 1); PG8_SCHED; PG8_LDA(At, 0, 0); PG8_STAGE(PG8_SA(1, 1), a1 + hstep, voffA);
            PG8_WAIT_V(8); PG8_WAIT_L(0); PG8_BAR; PG8_MMA(0, 0, At, B0); PG8_MMA(0, 1, At, B1); PG8_BAR; PG8_SCHED;
            PG8_LDA(At, 0, 1); PG8_STAGE(PG8_SB(0, 0), b2, voffB); PG8_STAGE(PG8_SB(0, 1), b2 + hstep, voffB); PG8_STAGE(PG8_SA(0, 0), a2, voffA);
            PG8_WAIT_V(8); PG8_WAIT_L(0); PG8_BAR; PG8_MMA(1, 0, At, B0); PG8_MMA(1, 1, At, B1); PG8_BAR; PG8_SCHED;
            PG8_LDB(B0, 1, 0); PG8_LDB(B1, 1, 1); PG8_SCHED; PG8_LDA(At, 1, 0); PG8_STAGE(PG8_SA(0, 1), a2 + hstep, voffA);
            PG8_WAIT_V(8); PG8_WAIT_L(0); PG8_BAR; PG8_MMA(0, 0, At, B0); PG8_MMA(0, 1, At, B1); PG8_BAR; PG8_SCHED;
            PG8_LDA(At, 1, 1); PG8_STAGE(PG8_SB(1, 0), b3, voffB); PG8_STAGE(PG8_SB(1, 1), b3 + hstep, voffB); PG8_STAGE(PG8_SA(1, 0), a3, voffA);
            PG8_WAIT_V(8); PG8_WAIT_L(0); PG8_BAR; PG8_MMA(1, 0, At, B0); PG8_MMA(1, 1, At, B1); PG8_BAR; PG8_SCHED;
            } else {
            PG8_LDB(B0, 0, 0); PG8_SCHED; PG8_LDA(At, 0, 0); PG8_STAGE(PG8_SA(1, 1), a1 + hstep, voffA);
            PG8_WAIT_L(8); PG8_BAR; PG8_WAIT_L(0); PG8_MMA(0, 0, At, B0); PG8_BAR; PG8_SCHED;
            PG8_LDB(B1, 0, 1); PG8_STAGE(PG8_SB(0, 0), b2, voffB);
            PG8_BAR; PG8_WAIT_L(0); PG8_MMA(0, 1, At, B1); PG8_BAR;
            PG8_LDA(At, 0, 1); PG8_STAGE(PG8_SA(0, 0), a2, voffA);
            PG8_BAR; PG8_WAIT_L(0); PG8_MMA(1, 0, At, B0); PG8_BAR; PG8_SCHED;
            PG8_STAGE(PG8_SB(0, 1), b2 + hstep, voffB);
            PG8_WAIT_V(6); PG8_BAR; PG8_MMA(1, 1, At, B1); PG8_BAR;
            PG8_LDB(B0, 1, 0); PG8_SCHED; PG8_LDA(At, 1, 0); PG8_STAGE(PG8_SA(0, 1), a2 + hstep, voffA);
            PG8_WAIT_L(8); PG8_BAR; PG8_WAIT_L(0); PG8_MMA(0, 0, At, B0); PG8_BAR; PG8_SCHED;
            PG8_LDB(B1, 1, 1); PG8_STAGE(PG8_SB(1, 0), b3, voffB);
            PG8_BAR; PG8_WAIT_L(0); PG8_MMA(0, 1, At, B1); PG8_BAR;
            PG8_LDA(At, 1, 1); PG8_STAGE(PG8_SA(1, 0), a3, voffA);
            PG8_BAR; PG8_WAIT_L(0); PG8_MMA(1, 0, At, B0); PG8_BAR; PG8_SCHED;
            PG8_STAGE(PG8_SB(1, 1), b3 + hstep, voffB);
            PG8_WAIT_V(6); PG8_BAR; PG8_MMA(1, 1, At, B1); PG8_BAR;
            }
        }
        if constexpr (ALIGN_EPI) { if (wr == 0) PG8_BAR; }
        if constexpr (!Epi::AFTER_DRAIN) { if constexpr (Epi::PREFETCH) E(acc, cur, wr, wc, fr, fq, epre); else E(acc, cur, wr, wc, fr, fq); S.done(cur); }
        if (!has_next) break;
#pragma unroll
        for (int a = 0; a < 2; ++a)
#pragma unroll
            for (int b = 0; b < 2; ++b)
#pragma unroll
                for (int m = 0; m < 4; ++m)
#pragma unroll
                    for (int n = 0; n < 2; ++n) acc[a][b][m][n] = (f32x4){0.f, 0.f, 0.f, 0.f};
        cur = nxt; cA = nA; cB = nB; ++ui;
        if constexpr (ALIGN_EPI) { if (wr == 1) PG8_BAR; }
    }
    PG8_WAIT_V(0);
    if constexpr (!ALIGN_EPI) { if (wr == 0) PG8_BAR; }
    PG8_BAR;
    if constexpr (Epi::AFTER_DRAIN) { E.fused(acc, cur, wr, wc, fr, fq, lds, wid, lane); S.done(cur); }
#undef PG8_SA
#undef PG8_SB
#undef PG8_STAGE
#undef PG8_LDA
#undef PG8_LDB
#undef PG8_MMA
#undef PG8_WAIT_V
#undef PG8_WAIT_L
#undef PG8_BAR
#undef PG8_SCHED
}
}

#ifndef MK_N_LAUNCHES
#define MK_N_LAUNCHES 1
#endif
#define LAS __attribute__((address_space(3)))
#define GAS __attribute__((address_space(1)))
using pg8::f32x4; using pg8::bf16_t; using pg8::Unit; using pg8::u32x4; using pg8::bf16x8;
typedef unsigned u32x2 __attribute__((ext_vector_type(2)));

constexpr int DM = 2048, TP = 8192, MTOT = 8320, MPAD = 8448, INC = 12800, DFF = 5632;
constexpr float EPS = 1e-6f;
constexpr size_t O_NKP = 17039360, O_NVP = 17301504, O_NCP = 17563648, O_NKS = 17580032, O_NVS = 17645568, O_NCS = 17711104, O_NGS = 18235392;
constexpr size_t WE_IN = (size_t)INC * DM, WE_BR = (size_t)3 * 2048 * 1024, WE_OUT = (size_t)DM * DM, WE_GU = (size_t)2 * DFF * DM, WE_DN = (size_t)DM * DFF;
constexpr size_t WE_LAYER = WE_IN + WE_BR + WE_OUT + WE_GU + WE_DN;
constexpr size_t WS_SSV = 0;
constexpr size_t WS_W = 1u << 20;
constexpr size_t WS_X = WS_W + 2 * WE_LAYER * 2;
constexpr size_t WS_XN = WS_X + (size_t)MPAD * DM * 4;
constexpr size_t WS_A = WS_XN + (size_t)MPAD * DM * 2;
constexpr size_t SZ1K = (size_t)MPAD * 1024 * 2;
constexpr size_t WS_Q = WS_A, WS_K = WS_Q + SZ1K, WS_V = WS_K + SZ1K / 4, WS_BG = WS_V + SZ1K / 4, WS_ZC = WS_BG + SZ1K, WS_U = WS_ZC + SZ1K, WS_VG = WS_U + SZ1K;
constexpr size_t WS_GT = WS_VG + SZ1K;
constexpr size_t WS_OA = WS_GT + (size_t)MPAD * 6144 * 2, WS_OB = WS_OA + SZ1K, WS_OC = WS_OB + SZ1K;
constexpr size_t WS_MG = WS_OC + SZ1K;
constexpr size_t WS_END = WS_MG + (size_t)MPAD * DM * 2;
constexpr size_t WS_TMP = WS_A;
constexpr size_t WS_H = WS_A;
static_assert((size_t)MPAD * DM * 4 <= WS_GT - WS_A && (size_t)MPAD * DFF * 2 <= WS_GT - WS_A, "overlay");
constexpr size_t WS_BAR = 0xA0000, WS_ZERO_LO = 0x90000, WS_ZERO_BYTES = 0x14000;
constexpr size_t WS_CNT = 0x90000;
constexpr size_t WS_PART = WS_END;
constexpr size_t WS_END2 = WS_PART + (size_t)22 * 128 * DM * 4;
constexpr size_t WS_PCNT = 0x94000;
constexpr size_t WS_SSQ = WS_END2;
constexpr size_t WS_RSTD = WS_SSQ + (size_t)MPAD * 32 * 4;
constexpr size_t WS_END3 = WS_RSTD + (size_t)MPAD * 4;
constexpr int LDS_BYTES = 147456;

typedef __bf16 bf16x2_t __attribute__((ext_vector_type(2)));
typedef float f32x2_t __attribute__((ext_vector_type(2)));
__device__ __forceinline__ unsigned pk(float lo, float hi) { unsigned r; asm volatile("s_nop 1\n\tv_cvt_pk_bf16_f32 %0, %1, %2" : "=v"(r) : "v"(lo), "v"(hi)); return r; }
__device__ __forceinline__ u32x4 pk8(f32x4 a, f32x4 b) { u32x4 w; w.x = pk(a[0], a[1]); w.y = pk(a[2], a[3]); w.z = pk(b[0], b[1]); w.w = pk(b[2], b[3]); return w; }
__device__ __forceinline__ float bflo(unsigned w) { return __uint_as_float(w << 16); }
__device__ __forceinline__ float bfhi(unsigned w) { return __uint_as_float(w & 0xffff0000u); }
__device__ __forceinline__ f32x4 unpk_lo(u32x4 w) { return (f32x4){bflo(w.x), bfhi(w.x), bflo(w.y), bfhi(w.y)}; }
__device__ __forceinline__ f32x4 unpk_hi(u32x4 w) { return (f32x4){bflo(w.z), bfhi(w.z), bflo(w.w), bfhi(w.w)}; }
__device__ __forceinline__ unsigned q8x4(f32x4 g) { const f32x4 v = g * 255.f + 0.5f; return (unsigned)v[0] | ((unsigned)v[1] << 8) | ((unsigned)v[2] << 16) | ((unsigned)v[3] << 24); }
__device__ __forceinline__ f32x4 dq8x4(unsigned w) { return (f32x4){(float)(w & 0xffu), (float)((w >> 8) & 0xffu), (float)((w >> 16) & 0xffu), (float)(w >> 24)} * (1.f / 255.f); }
__device__ __forceinline__ float sigm(float x) { return __builtin_amdgcn_rcpf(1.f + __expf(-x)); }
__device__ __forceinline__ float gelu_t(float x) { const float t = 1.5957691216f * (x + 0.044715f * x * x * x); return x * sigm(t); }
__device__ __forceinline__ f32x4 gelu4(f32x4 v) { return (f32x4){gelu_t(v[0]), gelu_t(v[1]), gelu_t(v[2]), gelu_t(v[3])}; }
__device__ __forceinline__ f32x4 sigm4(f32x4 v) { return (f32x4){sigm(v[0]), sigm(v[1]), sigm(v[2]), sigm(v[3])}; }
__device__ __forceinline__ float sq4(f32x4 v) { return (v[0] * v[0] + v[1] * v[1]) + (v[2] * v[2] + v[3] * v[3]); }
__device__ __forceinline__ float wave_sum(float v) {
#pragma unroll
    for (int o = 1; o < 64; o <<= 1) v += __shfl_xor(v, o);
    return v;
}
__device__ __forceinline__ float wave_max(float v) {
#pragma unroll
    for (int o = 1; o < 64; o <<= 1) v = fmaxf(v, __shfl_xor(v, o));
    return v;
}
#define LDS_WAIT() asm volatile("s_waitcnt lgkmcnt(0)" ::: "memory")
__device__ __forceinline__ float ssv_sum(const float* ssv, size_t row) {
    const f32x4 a = *(const GAS f32x4*)(ssv + row * 16), b = *(const GAS f32x4*)(ssv + row * 16 + 4), c = *(const GAS f32x4*)(ssv + row * 16 + 8), d = *(const GAS f32x4*)(ssv + row * 16 + 12);
    return (((a[0] + a[1]) + (a[2] + a[3])) + ((b[0] + b[1]) + (b[2] + b[3]))) + (((c[0] + c[1]) + (c[2] + c[3])) + ((d[0] + d[1]) + (d[2] + d[3])));
}
__device__ __forceinline__ int otid() { int t = threadIdx.x; asm volatile("" : "+v"(t)); return t; }

__device__ __forceinline__ void st_wt(float* p, float v) { __hip_atomic_store(p, v, __ATOMIC_RELAXED, __HIP_MEMORY_SCOPE_AGENT); }
__device__ __forceinline__ bool arrive_last(unsigned* cnt, unsigned total, bool release) {
    __shared__ unsigned s_last;
    asm volatile("s_waitcnt vmcnt(0)" ::: "memory");
    __syncthreads();
    if (threadIdx.x == 0) {
        if (release) { __builtin_amdgcn_fence(__ATOMIC_RELEASE, "agent"); asm volatile("s_waitcnt vmcnt(0)" ::: "memory"); }
        const unsigned old = __hip_atomic_fetch_add(cnt, 1u, __ATOMIC_RELAXED, __HIP_MEMORY_SCOPE_AGENT);
        s_last = (old + 1u == total) ? 1u : 0u;
    }
    __syncthreads();
    const bool last = s_last != 0u;
    if (last) { __builtin_amdgcn_fence(__ATOMIC_ACQUIRE, "agent"); asm volatile("s_waitcnt vmcnt(0)" ::: "memory"); }
    return last;
}
__device__ __forceinline__ float* keep_ptr(float* out, size_t offp, size_t offs, int layer, int pm, int ai, int row) {
    if (pm < 32) { if ((pm & 7) == 7 && ai == 1) { const int b = pm >> 3, tt = (row & 2047) - 1920; return out + offp + ((size_t)(layer * 4 + b) * 128 + tt) * 256; } return nullptr; }
    if (ai == 0) return out + offs + (size_t)(layer * 128 + (row - TP)) * 256;
    return nullptr;
}
struct EpiIn {
    static constexpr bool PERM = true, AFTER_DRAIN = false, PREFETCH = true;
    __device__ __forceinline__ void pre(float (&e)[8], const Unit& u, int wr, int fr) const {
#pragma unroll
        for (int i = 0; i < 8; ++i) e[i] = rstd[u.pm * 256 + wr * 64 + fr + (i >> 2) * 128 + (i & 3) * 16];
    }
    bf16_t *Q, *Kb, *Vb, *BG, *ZC, *U, *VG, *GT; float* ssv; const float *qn, *kn, *bgate; float* out; int layer; const float* rstd;
    __device__ __forceinline__ void operator()(f32x4 (&acc)[2][2][4][2], const Unit& u, int wr, int wc, int fr, int fq, const float (&epre)[8]) const {
        const int pn = u.pn, pm = u.pm, rb = pm * 256 + wr * 64 + fr;
#pragma unroll
        for (int ai = 0; ai < 2; ++ai)
#pragma unroll
            for (int m = 0; m < 4; ++m) { const float rs_ = epre[ai * 4 + m];
#pragma unroll
                for (int bj = 0; bj < 2; ++bj) { acc[ai][bj][m][0] *= rs_; acc[ai][bj][m][1] *= rs_; } }
        if (pn < 5) {
            const float* nw = pn < 4 ? qn : kn; const float osc = pn < 4 ? 0.125f : 1.f;
            f32x4 w[2][2];
#pragma unroll
            for (int bj = 0; bj < 2; ++bj)
#pragma unroll
                for (int n = 0; n < 2; ++n) w[bj][n] = *(const GAS f32x4*)(nw + 32 * bj + 8 * fq + 4 * n);
#pragma unroll
            for (int ai = 0; ai < 2; ++ai)
#pragma unroll
                for (int m = 0; m < 4; ++m) {
                    const int row = rb + ai * 128 + m * 16;
                    float ss = (sq4(acc[ai][0][m][0]) + sq4(acc[ai][0][m][1])) + (sq4(acc[ai][1][m][0]) + sq4(acc[ai][1][m][1]));
                    ss += __shfl_xor(ss, 16); ss += __shfl_xor(ss, 32);
                    const float rs = rsqrtf(ss * (1.f / 64.f) + EPS);
                    f32x4 o[2][2];
#pragma unroll
                    for (int bj = 0; bj < 2; ++bj)
#pragma unroll
                        for (int n = 0; n < 2; ++n) o[bj][n] = acc[ai][bj][m][n] * rs * w[bj][n];
                    if (pn < 4) { bf16_t* p = Q + (size_t)row * 1024 + (pn * 4 + wc) * 64 + 8 * fq;
#pragma unroll
                        for (int bj = 0; bj < 2; ++bj) *(GAS u32x4*)(p + 32 * bj) = pk8(o[bj][0] * osc, o[bj][1] * osc);
                    } else { bf16_t* p = Kb + (size_t)row * 256 + wc * 64 + 8 * fq;
#pragma unroll
                        for (int bj = 0; bj < 2; ++bj) *(GAS u32x4*)(p + 32 * bj) = pk8(o[bj][0], o[bj][1]);
                        float* dst = keep_ptr(out, O_NKP, O_NKS, layer, pm, ai, row);
                        if (dst) { dst += wc * 64 + 8 * fq;
#pragma unroll
                            for (int bj = 0; bj < 2; ++bj) { *(GAS f32x4*)(dst + 32 * bj) = o[bj][0]; *(GAS f32x4*)(dst + 32 * bj + 4) = o[bj][1]; } }
                    }
                }
        } else if (pn == 5) {
#pragma unroll
            for (int ai = 0; ai < 2; ++ai)
#pragma unroll
                for (int m = 0; m < 4; ++m) {
                    const int row = rb + ai * 128 + m * 16;
                    bf16_t* p = Vb + (size_t)row * 256 + wc * 64 + 8 * fq;
#pragma unroll
                    for (int bj = 0; bj < 2; ++bj) *(GAS u32x4*)(p + 32 * bj) = pk8(acc[ai][bj][m][0], acc[ai][bj][m][1]);
                    float* dst = keep_ptr(out, O_NVP, O_NVS, layer, pm, ai, row);
                    if (dst) { dst += wc * 64 + 8 * fq;
#pragma unroll
                        for (int bj = 0; bj < 2; ++bj) { *(GAS f32x4*)(dst + 32 * bj) = acc[ai][bj][m][0]; *(GAS f32x4*)(dst + 32 * bj + 4) = acc[ai][bj][m][1]; } }
                }
        } else if (pn < 10) {
#pragma unroll
            for (int ai = 0; ai < 2; ++ai)
#pragma unroll
                for (int m = 0; m < 4; ++m) {
                    bf16_t* p = BG + (size_t)(rb + ai * 128 + m * 16) * 1024 + (pn - 6) * 256 + wc * 32 + 8 * fq;
#pragma unroll
                    for (int bj = 0; bj < 2; ++bj) *(GAS u32x4*)(p + 128 * bj) = pk8(acc[ai][bj][m][0], acc[ai][bj][m][1]);
                }
        } else if (pn < 18) {
#pragma unroll
            for (int ai = 0; ai < 2; ++ai)
#pragma unroll
                for (int m = 0; m < 4; ++m) {
                    bf16_t* p = ZC + (size_t)(rb + ai * 128 + m * 16) * 1024 + (pn - 10) * 128 + wc * 32 + 8 * fq;
                    *(GAS u32x4*)p = pk8(acc[ai][0][m][0] * acc[ai][1][m][0], acc[ai][0][m][1] * acc[ai][1][m][1]);
                }
        } else if (pn < 22) {
#pragma unroll
            for (int ai = 0; ai < 2; ++ai)
#pragma unroll
                for (int m = 0; m < 4; ++m) {
                    bf16_t* p = U + (size_t)(rb + ai * 128 + m * 16) * 1024 + (pn - 18) * 256 + wc * 32 + 8 * fq;
#pragma unroll
                    for (int bj = 0; bj < 2; ++bj) *(GAS u32x4*)(p + 128 * bj) = pk8(gelu4(acc[ai][bj][m][0]), gelu4(acc[ai][bj][m][1]));
                }
        } else if (pn < 26) {
#pragma unroll
            for (int ai = 0; ai < 2; ++ai)
#pragma unroll
                for (int m = 0; m < 4; ++m) {
                    const int row = rb + ai * 128 + m * 16;
                    bf16_t* p = VG + (size_t)row * 1024 + (pn - 22) * 256 + wc * 32 + 8 * fq;
                    float ss = 0.f;
#pragma unroll
                    for (int bj = 0; bj < 2; ++bj) { const f32x4 a = gelu4(acc[ai][bj][m][0]), b = gelu4(acc[ai][bj][m][1]); ss += sq4(a) + sq4(b); *(GAS u32x4*)(p + 128 * bj) = pk8(a, b); }
                    ss += __shfl_xor(ss, 16); ss += __shfl_xor(ss, 32);
                    if (fq == 0) ssv[(size_t)row * 16 + (pn - 22) * 4 + wc] = ss;
                }
        } else {
            const int gi = (pn - 26) * 256 + wc * 32 + 8 * fq;
            f32x4 bv[2][2];
#pragma unroll
            for (int bj = 0; bj < 2; ++bj)
#pragma unroll
                for (int n = 0; n < 2; ++n) bv[bj][n] = *(const GAS f32x4*)(bgate + gi + 128 * bj + 4 * n);
#pragma unroll
            for (int ai = 0; ai < 2; ++ai)
#pragma unroll
                for (int m = 0; m < 4; ++m) {
                    unsigned char* p = (unsigned char*)GT + (size_t)(rb + ai * 128 + m * 16) * 6144 + gi;
#pragma unroll
                    for (int bj = 0; bj < 2; ++bj) { u32x2 w; w.x = q8x4(sigm4(acc[ai][bj][m][0] + bv[bj][0])); w.y = q8x4(sigm4(acc[ai][bj][m][1] + bv[bj][1])); *(GAS u32x2*)(p + 128 * bj) = w; }
                }
        }
    }
};
struct EpiBranch {
    static constexpr bool PERM = true, AFTER_DRAIN = false, PREFETCH = false;
    const bf16_t* GT; bf16_t* MG; float* PART; unsigned* cnt;
    __device__ __forceinline__ void operator()(const f32x4 (&acc)[2][2][4][2], const Unit& u, int wr, int wc, int fr, int fq) const { run(acc, u, wr, wc, fr, fq, u.ab); }
    __device__ __forceinline__ void run(const f32x4 (&acc)[2][2][4][2], const Unit& u, int wr, int wc, int fr, int fq, const int bi) const {
        const int rb = u.pm * 256 + wr * 64 + fr, cb = u.pn * 256 + wc * 32 + 8 * fq;
        if (u.part >= 0) {
#pragma unroll
            for (int m = 0; m < 4; ++m) {
                const int r = wr * 64 + m * 16 + fr;
#pragma unroll
                for (int bj = 0; bj < 2; ++bj) {
                    const int col = cb + 128 * bj;
                    const u32x2 g = *(const GAS u32x2*)((const unsigned char*)GT + (size_t)(TP + r) * 6144 + bi * 2048 + col);
                    float* p = PART + ((size_t)(bi * 4 + u.part) * 128 + r) * 2048 + col;
                    *(GAS f32x4*)p = acc[0][bj][m][0] * dq8x4(g.x); *(GAS f32x4*)(p + 4) = acc[0][bj][m][1] * dq8x4(g.y);
                }
            }
            if (arrive_last(cnt + 64 * u.pn, 12u, true)) {
                const int tid = otid();
#pragma unroll 2
                for (int i = 0; i < 16; ++i) {
                    const int idx = tid + 512 * i, r = idx >> 6, col = u.pn * 256 + (idx & 63) * 4;
                    f32x4 s = (f32x4){0.f, 0.f, 0.f, 0.f};
                    f32x4 t[12];
#pragma unroll
                    for (int k = 0; k < 12; ++k) t[k] = *(const GAS f32x4*)(PART + ((size_t)k * 128 + r) * 2048 + col);
#pragma unroll
                    for (int k = 0; k < 12; ++k) s += t[k];
                    u32x2 w; w.x = pk(s[0], s[1]); w.y = pk(s[2], s[3]);
                    *(GAS u32x2*)(MG + (size_t)(TP + r) * 2048 + col) = w;
                }
            }
            return;
        }
#pragma unroll
        for (int ai = 0; ai < 2; ++ai)
#pragma unroll
            for (int m = 0; m < 4; ++m) {
                const size_t row = (size_t)(rb + ai * 128 + m * 16);
#pragma unroll
                for (int bj = 0; bj < 2; ++bj) {
                    const int col = cb + 128 * bj;
                    const u32x2 g = *(const GAS u32x2*)((const unsigned char*)GT + row * 6144 + bi * 2048 + col);
                    f32x4 v0 = acc[ai][bj][m][0] * dq8x4(g.x), v1 = acc[ai][bj][m][1] * dq8x4(g.y);
                    bf16_t* t = MG + row * 2048 + col;
                    if (bi > 0) { const u32x4 o = *(const GAS u32x4*)t; v0 += unpk_lo(o); v1 += unpk_hi(o); }
                    *(GAS u32x4*)t = pk8(v0, v1);
                }
            }
    }
};
__device__ __forceinline__ float rstd_from_ssq(const float* p) {
    float s = 0.f;
#pragma unroll
    for (int i = 0; i < 8; ++i) { const f32x4 v = *(const GAS f32x4*)(p + 4 * i); s += (v[0] + v[1]) + (v[2] + v[3]); }
    return rsqrtf(s * (1.f / DM) + EPS);
}
struct EpiBranch1 {
    static constexpr bool PERM = true, AFTER_DRAIN = false, PREFETCH = false;
    const bf16_t* GT; bf16_t* MG; float* PART; unsigned* cnt; int bi;
    __device__ __forceinline__ void operator()(const f32x4 (&acc)[2][2][4][2], const Unit& u, int wr, int wc, int fr, int fq) const { const EpiBranch E{GT, MG, PART, cnt}; E.run(acc, u, wr, wc, fr, fq, bi); }
};
struct EpiRes {
    static constexpr bool PERM = true, AFTER_DRAIN = false, PREFETCH = false;
    int mode; const float* basef; const float* sbasef; bf16_t* xb; float* dst; int nrows; float* PART; unsigned* cnt; int nsplit; float* ssq; float* rstd; unsigned* pcnt;
    __device__ __forceinline__ void operator()(const f32x4 (&acc)[2][2][4][2], const Unit& u, int wr, int wc, int fr, int fq) const {
        const int rb = u.pm * 256 + wr * 64 + fr, cb = u.pn * 256 + wc * 32 + 8 * fq;
        if (u.part >= 0) {
#pragma unroll
            for (int m = 0; m < 4; ++m) {
                const int r = wr * 64 + m * 16 + fr;
#pragma unroll
                for (int bj = 0; bj < 2; ++bj) {
                    float* p = PART + ((size_t)u.part * 128 + r) * 2048 + cb + 128 * bj;
                    *(GAS f32x4*)p = acc[0][bj][m][0]; *(GAS f32x4*)(p + 4) = acc[0][bj][m][1];
                }
            }
            if (arrive_last(cnt + 64 * u.pn, (unsigned)nsplit, true)) {
                const int tid = otid(), lane = tid & 63;
#pragma unroll 4
                for (int i = 0; i < 16; ++i) {
                    const int idx = tid + 512 * i, r = idx >> 6, col = u.pn * 256 + (idx & 63) * 4;
                    const size_t off = (size_t)(TP + r) * 2048 + col;
                    f32x4 s;
                    if (mode == 0) s = *(const GAS f32x4*)(sbasef + off);
                    else { const u32x2 h = *(const GAS u32x2*)(xb + off); s = (f32x4){bflo(h.x), bfhi(h.x), bflo(h.y), bfhi(h.y)}; }
                    for (int k0 = 0; k0 < nsplit; k0 += 12) {
                        f32x4 t[12];
#pragma unroll
                        for (int j = 0; j < 12; ++j) if (k0 + j < nsplit) t[j] = *(const GAS f32x4*)(PART + ((size_t)(k0 + j) * 128 + r) * 2048 + col);
#pragma unroll
                        for (int j = 0; j < 12; ++j) if (k0 + j < nsplit) s += t[j];
                    }
                    if (mode == 2) *(GAS f32x4*)(dst + off) = s;
                    else {
                        u32x2 w; w.x = pk(s[0], s[1]); w.y = pk(s[2], s[3]); *(GAS u32x2*)(xb + off) = w;
                        const float q = wave_sum(sq4(s));
                        if (lane < 4) st_wt(ssq + (size_t)(TP + r) * 32 + u.pn * 4 + lane, lane == 0 ? q : 0.f);
                    }
                }
                if (mode != 2) { if (arrive_last(pcnt + 64 * 32, 8u, false)) { if (tid < 128) rstd[TP + tid] = rstd_from_ssq(ssq + (size_t)(TP + tid) * 32); } }
            }
            return;
        }
#pragma unroll
        for (int ai = 0; ai < 2; ++ai)
#pragma unroll
            for (int m = 0; m < 4; ++m) {
                const int row = rb + ai * 128 + m * 16;
                if (row < nrows) {
                    float ss = 0.f;
#pragma unroll
                    for (int bj = 0; bj < 2; ++bj) {
                        const size_t off = (size_t)row * 2048 + cb + 128 * bj;
                        f32x4 b0, b1;
                        if (mode == 0) { b0 = *(const GAS f32x4*)(basef + off); b1 = *(const GAS f32x4*)(basef + off + 4); }
                        else { const u32x4 h = *(const GAS u32x4*)(xb + off); b0 = unpk_lo(h); b1 = unpk_hi(h); }
                        const f32x4 x0 = b0 + acc[ai][bj][m][0], x1 = b1 + acc[ai][bj][m][1];
                        if (mode == 2) { *(GAS f32x4*)(dst + off) = x0; *(GAS f32x4*)(dst + off + 4) = x1; }
                        else { *(GAS u32x4*)(xb + off) = pk8(x0, x1); ss += sq4(x0) + sq4(x1); }
                    }
                    if (mode != 2) { ss += __shfl_xor(ss, 16); ss += __shfl_xor(ss, 32); if (fq == 0) st_wt(ssq + (size_t)row * 32 + u.pn * 4 + wc, ss); }
                }
            }
        if (mode != 2) { if (arrive_last(pcnt + 64 * u.pm, 8u, false)) { const int tid = otid(); if (tid < 256) rstd[u.pm * 256 + tid] = rstd_from_ssq(ssq + (size_t)(u.pm * 256 + tid) * 32); } }
    }
};
struct EpiGU {
    static constexpr bool PERM = true, AFTER_DRAIN = false, PREFETCH = true;
    __device__ __forceinline__ void pre(float (&e)[8], const Unit& u, int wr, int fr) const {
#pragma unroll
        for (int i = 0; i < 8; ++i) e[i] = rstd[u.pm * 256 + wr * 64 + fr + (i >> 2) * 128 + (i & 3) * 16];
    }
    bf16_t* H; const float* rstd;
    __device__ __forceinline__ void operator()(f32x4 (&acc)[2][2][4][2], const Unit& u, int wr, int wc, int fr, int fq, const float (&epre)[8]) const {
        const int rb = u.pm * 256 + wr * 64 + fr, cb = u.pn * 128 + wc * 32 + 8 * fq;
#pragma unroll
        for (int ai = 0; ai < 2; ++ai)
#pragma unroll
            for (int m = 0; m < 4; ++m) { const float rs_ = epre[ai * 4 + m];
#pragma unroll
                for (int bj = 0; bj < 2; ++bj) { acc[ai][bj][m][0] *= rs_; acc[ai][bj][m][1] *= rs_; } }
#pragma unroll
        for (int ai = 0; ai < 2; ++ai)
#pragma unroll
            for (int m = 0; m < 4; ++m) {
                const f32x4 g0 = acc[ai][0][m][0], g1 = acc[ai][0][m][1];
                const f32x4 h0 = g0 * sigm4(g0) * acc[ai][1][m][0], h1 = g1 * sigm4(g1) * acc[ai][1][m][1];
                *(GAS u32x4*)(H + (size_t)(rb + ai * 128 + m * 16) * DFF + cb) = pk8(h0, h1);
            }
    }
};

__device__ __forceinline__ int map_in(int n0d) {
    const int pn = n0d >> 8, p = n0d & 255;
    if (pn < 6) { const int bj = p >> 7, wc = (p >> 5) & 3; return pn * 256 + 64 * wc + 32 * bj; }
    if (pn >= 10 && pn < 18) return (p < 128 ? 2560 : 3584) + (pn - 10) * 128 + (p & 127);
    return n0d;
}
__device__ __forceinline__ int map_gu(int n0d) { const int pn = n0d >> 8, p = n0d & 255; return (p < 128 ? 0 : DFF) + pn * 128 + (p & 127); }
constexpr int I_IN = 32 * 400, I_BR = 3 * 16 * 64, I_OUT = 32 * 64, I_GU = 32 * 352, I_DN = 88 * 64, I_LAYER = I_IN + I_BR + I_OUT + I_GU + I_DN;
__device__ __constant__ float CVT_ONES[64] = {1,1,1,1,1,1,1,1,1,1,1,1,1,1,1,1,1,1,1,1,1,1,1,1,1,1,1,1,1,1,1,1,1,1,1,1,1,1,1,1,1,1,1,1,1,1,1,1,1,1,1,1,1,1,1,1,1,1,1,1,1,1,1,1};
struct CvtItem { const float* src; bf16_t* dst; const float* gk; int N, K; };
struct CvtSrc { const float *w_in, *w_br, *w_out, *w_gu, *w_dn; bf16_t* WB; const float *g_mix, *g_ffn; };
__device__ __forceinline__ CvtItem cvt_decode(const CvtSrc& s, int it) {
    const int l = it / I_LAYER; int r = it % I_LAYER;
    bf16_t* wl = s.WB + (size_t)l * WE_LAYER;
    const float* W; const float* gk = nullptr; int N, K, kb, nb, sc;
#define CVT_KN(r_, NB_) do { kb = (r_) / (NB_); nb = (r_) % (NB_); } while (0)
    if (r < I_IN) { CVT_KN(r, 400); W = s.w_in + (size_t)l * DM * INC; N = INC; K = DM; sc = map_in(nb * 32); gk = s.g_mix + l * DM; }
    else if ((r -= I_IN) < I_BR) { const int bi = r / 1024, r2 = r % 1024; CVT_KN(r2, 64); W = s.w_br + (size_t)(l * 3 + bi) * 1024 * 2048; N = 2048; K = 1024; sc = nb * 32; wl += WE_IN + (size_t)bi * 2048 * 1024; }
    else if ((r -= I_BR) < I_OUT) { CVT_KN(r, 64); W = s.w_out + (size_t)l * DM * DM; N = DM; K = DM; sc = nb * 32; wl += WE_IN + WE_BR; }
    else if ((r -= I_OUT) < I_GU) { CVT_KN(r, 352); W = s.w_gu + (size_t)l * DM * 2 * DFF; N = 2 * DFF; K = DM; sc = map_gu(nb * 32); gk = s.g_ffn + l * DM; wl += WE_IN + WE_BR + WE_OUT; }
    else { r -= I_GU; CVT_KN(r, 64); W = s.w_dn + (size_t)l * DFF * DM; N = DM; K = DFF; sc = nb * 32; wl += WE_IN + WE_BR + WE_OUT + WE_GU; }
    CvtItem o; o.src = W + (size_t)(kb * 64) * N + sc; o.dst = wl + (size_t)(nb * 32) * K + kb * 64; o.N = N; o.K = K; o.gk = gk ? gk + kb * 64 : (const float*)CVT_ONES; return o;
}
__device__ __forceinline__ void cvt_load(const CvtItem& it, f32x4 (&v)[8], f32x4 (&g)[2], int lane) {
    g[0] = *(const GAS f32x4*)(it.gk + 8 * (lane & 7)); g[1] = *(const GAS f32x4*)(it.gk + 8 * (lane & 7) + 4);
    const float* src = it.src + (size_t)(lane >> 3) * it.N + 4 * (lane & 7);
#pragma unroll
    for (int i = 0; i < 8; ++i) v[i] = __builtin_nontemporal_load((const GAS f32x4*)(src + (size_t)(8 * i) * it.N));
}
__device__ __forceinline__ void cvt_store(const CvtItem& it, const f32x4 (&v)[8], const f32x4 (&g)[2], LAS float* scr, int lane) {
#pragma unroll
    for (int i = 0; i < 8; ++i) { LAS float* d = scr + (8 * i + (lane >> 3)) * 33 + 4 * (lane & 7); d[0] = v[i][0]; d[1] = v[i][1]; d[2] = v[i][2]; d[3] = v[i][3]; }
    LDS_WAIT();
    const int c = lane & 7;
    const f32x4 g0 = g[0], g1 = g[1];
#pragma unroll
    for (int j = 0; j < 4; ++j) { const int n = (lane >> 3) + 8 * j; const LAS float* s = scr + (8 * c) * 33 + n;
        u32x4 o; o.x = pk(s[0 * 33] * g0[0], s[1 * 33] * g0[1]); o.y = pk(s[2 * 33] * g0[2], s[3 * 33] * g0[3]); o.z = pk(s[4 * 33] * g1[0], s[5 * 33] * g1[1]); o.w = pk(s[6 * 33] * g1[2], s[7 * 33] * g1[3]);
        *(GAS u32x4*)(it.dst + (size_t)n * it.K + 8 * c) = o; }
    LDS_WAIT();
}
__device__ __forceinline__ void convert_weights(const CvtSrc& s, int it_lo, int it_hi, LAS float* scr, int gw, int NGW, int lane) {
    int it = it_lo + gw; if (it >= it_hi) return;
    CvtItem cur = cvt_decode(s, it); f32x4 v[8], gv[2]; cvt_load(cur, v, gv, lane);
    for (;;) {
        const int nit = it + NGW; const bool more = nit < it_hi;
        const CvtItem nxt = cvt_decode(s, more ? nit : it); f32x4 w[8], gw2[2];
        cvt_load(nxt, w, gw2, lane);
        cvt_store(cur, v, gv, scr, lane);
        if (!more) break;
#pragma unroll
        for (int i = 0; i < 8; ++i) v[i] = w[i];
        gv[0] = gw2[0]; gv[1] = gw2[1];
        cur = nxt; it = nit;
    }
}
__device__ __forceinline__ void prep_rows(const float* xp, const float* xs, bf16_t* XN, float* rstd, int gw, int NGW, int lane) {
    for (int r = gw; r < MTOT; r += NGW) {
        const float* src = r < TP ? xp + (size_t)r * DM : xs + (size_t)(r - TP) * DM;
        f32x4 v[8]; float ss = 0.f;
#pragma unroll
        for (int j = 0; j < 8; ++j) { v[j] = ((const GAS f32x4*)src)[lane + 64 * j]; ss += sq4(v[j]); }
        ss = wave_sum(ss);
#pragma unroll
        for (int j = 0; j < 8; ++j) { u32x2 w; w.x = pk(v[j][0], v[j][1]); w.y = pk(v[j][2], v[j][3]); ((GAS u32x2*)(XN + (size_t)r * DM))[lane + 64 * j] = w; }
        if (lane == 0) rstd[r] = rsqrtf(ss * (1.f / DM) + EPS);
    }
}

struct MixP {
    const bf16_t *Q, *Kb, *Vb, *BG, *ZC, *U, *VG; bf16_t *OA, *OB, *OC; const float* ssv;
    const float *ck, *cv, *sc, *sinks, *convw, *vnorm, *wsp, *bsp; float* out; int layer;
};
constexpr int KS_STR = 144, VT_STR = 528, VT_OFF = 256 * KS_STR;
__device__ __forceinline__ void attn_unit(LAS unsigned char* lds, const MixP& P, int b, int n, int kvh) {
    const int tid = otid(), wid = tid >> 6, lane = tid & 63, fr = lane & 15, fq = lane >> 4;
    const int row0 = b * 2048 + (n - 1) * 128;
    const int g = wid >> 1, head = kvh * 4 + g;
    const bf16_t* qp = P.Q + (size_t)(b * 2048 + n * 128 + (wid & 1) * 64 + fr) * 1024 + head * 64 + 8 * fq;
    bf16x8 qn0 = *(const GAS bf16x8*)qp, qn1 = *(const GAS bf16x8*)(qp + 32);
#pragma unroll
    for (int i = 0; i < 4; ++i) {
        const int idx = tid + 512 * i, c = idx >> 3, ch = idx & 7;
        u32x4 kv = (u32x4){0u, 0u, 0u, 0u}, vv = kv;
        if (n > 0 || c >= 128) { kv = *(const GAS u32x4*)(P.Kb + (size_t)(row0 + c) * 256 + kvh * 64 + ch * 8); vv = *(const GAS u32x4*)(P.Vb + (size_t)(row0 + c) * 256 + kvh * 64 + ch * 8); }
        *(LAS u32x4*)(lds + c * KS_STR + ch * 16) = kv;
        LAS unsigned short* vt = (LAS unsigned short*)(lds + VT_OFF + (ch * 8) * VT_STR + c * 2);
        vt[0 * (VT_STR / 2)] = (unsigned short)(vv.x & 0xffff); vt[1 * (VT_STR / 2)] = (unsigned short)(vv.x >> 16);
        vt[2 * (VT_STR / 2)] = (unsigned short)(vv.y & 0xffff); vt[3 * (VT_STR / 2)] = (unsigned short)(vv.y >> 16);
        vt[4 * (VT_STR / 2)] = (unsigned short)(vv.z & 0xffff); vt[5 * (VT_STR / 2)] = (unsigned short)(vv.z >> 16);
        vt[6 * (VT_STR / 2)] = (unsigned short)(vv.w & 0xffff); vt[7 * (VT_STR / 2)] = (unsigned short)(vv.w >> 16);
    }
    __syncthreads();
    const float slope = exp2f(-0.5f * (float)(head + 1)), sink = P.sinks[head];
    const int e0 = fr - 4 * fq;
    float lb[4];
#pragma unroll
    for (int r = 0; r < 4; ++r) lb[r] = -slope * (float)(e0 - r);
#pragma unroll 1
    for (int qt = 0; qt < 4; ++qt) {
        const bf16x8 q0 = qn0, q1 = qn1;
        if (qt < 3) { qn0 = *(const GAS bf16x8*)(qp + (size_t)(qt + 1) * 16 * 1024); qn1 = *(const GAS bf16x8*)(qp + (size_t)(qt + 1) * 16 * 1024 + 32); }
        const int kt0 = (wid & 1) * 4 + qt;
        const size_t qrow = (size_t)(b * 2048 + n * 128 + 16 * kt0 + fr);
        const LAS unsigned char* kb = lds + (16 * kt0 + fr) * KS_STR + 16 * fq;
        f32x4 s[9];
#pragma unroll
        for (int j = 0; j < 9; ++j) {
            const bf16x8 k0 = *(const LAS bf16x8*)(kb + j * 16 * KS_STR), k1 = *(const LAS bf16x8*)(kb + j * 16 * KS_STR + 64);
            f32x4 a = (f32x4){0.f, 0.f, 0.f, 0.f};
            a = __builtin_amdgcn_mfma_f32_16x16x32_bf16(k0, q0, a, 0, 0, 0);
            a = __builtin_amdgcn_mfma_f32_16x16x32_bf16(k1, q1, a, 0, 0, 0);
            s[j] = a;
        }
        float mx = sink;
#pragma unroll
        for (int j = 0; j < 9; ++j) {
            const float tb = -slope * (float)(128 - 16 * j);
            const bool dead = (n == 0) && (kt0 + j < 8);
#pragma unroll
            for (int r = 0; r < 4; ++r) {
                float v = s[j][r] + (tb + lb[r]);
                if (j == 0 && e0 - r >= 0) v = -1e30f;
                if (j == 8 && e0 - r < 0) v = -1e30f;
                if (dead) v = -1e30f;
                s[j][r] = v; mx = fmaxf(mx, v);
            }
        }
        mx = fmaxf(mx, __shfl_xor(mx, 16)); mx = fmaxf(mx, __shfl_xor(mx, 32));
        float sum = 0.f;
#pragma unroll
        for (int j = 0; j < 9; ++j)
#pragma unroll
            for (int r = 0; r < 4; ++r) { const float p = __expf(s[j][r] - mx); s[j][r] = p; sum += p; }
        sum += __shfl_xor(sum, 16); sum += __shfl_xor(sum, 32);
        const float inv = 1.f / (sum + __expf(sink - mx));
        f32x4 o[4];
#pragma unroll
        for (int dt = 0; dt < 4; ++dt) o[dt] = (f32x4){0.f, 0.f, 0.f, 0.f};
        const LAS unsigned char* vbase = lds + VT_OFF + fr * VT_STR + (16 * kt0 + 4 * fq) * 2;
#pragma unroll
        for (int kp = 0; kp < 5; ++kp) {
            const f32x4 z4 = (f32x4){0.f, 0.f, 0.f, 0.f};
            const u32x4 pw = pk8(s[2 * kp], kp < 4 ? s[2 * kp + 1] : z4);
            const bf16x8 pf = __builtin_bit_cast(bf16x8, pw);
#pragma unroll
            for (int dt = 0; dt < 4; ++dt) {
                const LAS unsigned char* vb = vbase + (16 * dt) * VT_STR + 64 * kp;
                const u32x2 v0 = *(const LAS u32x2*)vb, v1 = *(const LAS u32x2*)(vb + (kp < 4 ? 32 : 0));
                const u32x4 vw = (u32x4){v0.x, v0.y, v1.x, v1.y};
                o[dt] = __builtin_amdgcn_mfma_f32_16x16x32_bf16(__builtin_bit_cast(bf16x8, vw), pf, o[dt], 0, 0, 0);
            }
        }
#pragma unroll
        for (int dt = 0; dt < 4; ++dt) { const f32x4 ov = o[dt] * inv; u32x2 w; w.x = pk(ov[0], ov[1]); w.y = pk(ov[2], ov[3]);
            *(GAS u32x2*)(P.OA + qrow * 1024 + head * 64 + 16 * dt + 4 * fq) = w; }
    }
    __syncthreads();
}
constexpr int G_STR = 272, G_WOFF = 128 * G_STR;
__device__ __forceinline__ void gmlp_unit(LAS unsigned char* lds, const MixP& P, int b, int n, int g) {
    const int tid = otid(), wid = tid >> 6, lane = tid & 63, fr = lane & 15, fq = lane >> 4;
    const int row0 = b * 2048 + n * 128;
#pragma unroll
    for (int i = 0; i < 4; ++i) {
        const int idx = tid + 512 * i, q = idx >> 4, ch = idx & 15;
        const u32x4 raw = *(const GAS u32x4*)(P.VG + (size_t)(row0 + q) * 1024 + g * 128 + ch * 8);
        const float rs = rsqrtf(ssv_sum(P.ssv, (size_t)(row0 + q)) * (1.f / 1024.f) + EPS);
        const f32x4 n0 = *(const GAS f32x4*)(P.vnorm + g * 128 + ch * 8), n1 = *(const GAS f32x4*)(P.vnorm + g * 128 + ch * 8 + 4);
        const f32x4 a = unpk_lo(raw) * rs * n0, c = unpk_hi(raw) * rs * n1;
        const u32x4 w = pk8(a, c);
        LAS unsigned short* vt = (LAS unsigned short*)(lds + (ch * 8) * G_STR + q * 2);
        vt[0 * (G_STR / 2)] = (unsigned short)(w.x & 0xffff); vt[1 * (G_STR / 2)] = (unsigned short)(w.x >> 16);
        vt[2 * (G_STR / 2)] = (unsigned short)(w.y & 0xffff); vt[3 * (G_STR / 2)] = (unsigned short)(w.y >> 16);
        vt[4 * (G_STR / 2)] = (unsigned short)(w.z & 0xffff); vt[5 * (G_STR / 2)] = (unsigned short)(w.z >> 16);
        vt[6 * (G_STR / 2)] = (unsigned short)(w.w & 0xffff); vt[7 * (G_STR / 2)] = (unsigned short)(w.w >> 16);
        const int p = idx >> 4, qc = idx & 15;
        const float* wp = P.wsp + (size_t)g * 16384 + p * 128 + qc * 8;
        f32x4 w0 = *(const GAS f32x4*)wp, w1 = *(const GAS f32x4*)(wp + 4);
#pragma unroll
        for (int e = 0; e < 4; ++e) { if (qc * 8 + e > p) w0[e] = 0.f; if (qc * 8 + 4 + e > p) w1[e] = 0.f; }
        *(LAS u32x4*)(lds + G_WOFF + p * G_STR + qc * 16) = pk8(w0, w1);
    }
    __syncthreads();
    bf16x8 af[4];
#pragma unroll
    for (int kk = 0; kk < 4; ++kk) af[kk] = *(const LAS bf16x8*)(lds + (16 * wid + fr) * G_STR + (32 * kk + 8 * fq) * 2);
#pragma unroll
    for (int pt = 0; pt < 8; ++pt) {
        f32x4 d = (f32x4){0.f, 0.f, 0.f, 0.f};
#pragma unroll
        for (int kk = 0; kk < 4; ++kk) if (32 * kk <= 16 * pt + 15) {
            const bf16x8 bf = *(const LAS bf16x8*)(lds + G_WOFF + (16 * pt + fr) * G_STR + (32 * kk + 8 * fq) * 2);
            d = __builtin_amdgcn_mfma_f32_16x16x32_bf16(af[kk], bf, d, 0, 0, 0);
        }
        const size_t off = (size_t)(row0 + 16 * pt + fr) * 1024 + g * 128 + 16 * wid + 4 * fq;
        const float bias = P.bsp[g * 128 + 16 * pt + fr];
        const u32x2 uu = *(const GAS u32x2*)(P.U + off);
        u32x2 w; w.x = pk(bflo(uu.x) * (d[0] + bias), bfhi(uu.x) * (d[1] + bias)); w.y = pk(bflo(uu.y) * (d[2] + bias), bfhi(uu.y) * (d[3] + bias));
        *(GAS u32x2*)(P.OC + off) = w;
    }
    __syncthreads();
}
__device__ __forceinline__ void conv_item(const MixP& P, int row, int ch) {
    const size_t off = (size_t)row * 1024 + ch;
    const u32x4 bgw = *(const GAS u32x4*)(P.BG + off), z0w = *(const GAS u32x4*)(P.ZC + off);
    const f32x4 z0a = unpk_lo(z0w), z0b = unpk_hi(z0w);
    f32x4 z1a, z1b, z2a, z2b;
    if (row < TP) {
        const int t = row & 2047;
        u32x4 z1w = (u32x4){0u, 0u, 0u, 0u}, z2w = z1w;
        if (t >= 1) z1w = *(const GAS u32x4*)(P.ZC + off - 1024);
        if (t >= 2) z2w = *(const GAS u32x4*)(P.ZC + off - 2048);
        z1a = unpk_lo(z1w); z1b = unpk_hi(z1w); z2a = unpk_lo(z2w); z2b = unpk_hi(z2w);
        if (t >= 2046) { float* d = P.out + O_NCP + ((size_t)(P.layer * 4 + (row >> 11)) * 2 + (t - 2046)) * 1024 + ch; *(GAS f32x4*)d = z0a; *(GAS f32x4*)(d + 4) = z0b; }
    } else {
        const int sb = row - TP;
        const float* s = P.sc + (size_t)sb * 2048 + ch;
        z2a = *(const GAS f32x4*)s; z2b = *(const GAS f32x4*)(s + 4); z1a = *(const GAS f32x4*)(s + 1024); z1b = *(const GAS f32x4*)(s + 1028);
        float* d = P.out + O_NCS + ((size_t)(P.layer * 128 + sb) * 2) * 1024 + ch;
        *(GAS f32x4*)d = z1a; *(GAS f32x4*)(d + 4) = z1b; *(GAS f32x4*)(d + 1024) = z0a; *(GAS f32x4*)(d + 1028) = z0b;
    }
    const float* cw = P.convw + ch;
    const f32x4 w0a = *(const GAS f32x4*)cw, w0b = *(const GAS f32x4*)(cw + 4), w1a = *(const GAS f32x4*)(cw + 1024), w1b = *(const GAS f32x4*)(cw + 1028), w2a = *(const GAS f32x4*)(cw + 2048), w2b = *(const GAS f32x4*)(cw + 2052);
    const f32x4 oa = unpk_lo(bgw) * (w0a * z2a + w1a * z1a + w2a * z0a), ob = unpk_hi(bgw) * (w0b * z2b + w1b * z1b + w2b * z0b);
    *(GAS u32x4*)(P.OB + off) = pk8(oa, ob);
}
__device__ __forceinline__ void sgmlp_item(const MixP& P, int sb, int ch) {
    const int g = ch >> 7;
    const size_t row = (size_t)(TP + sb), off = row * 1024 + ch;
    const u32x4 raw = *(const GAS u32x4*)(P.VG + off), uw = *(const GAS u32x4*)(P.U + off);
    const float rs = rsqrtf(ssv_sum(P.ssv, row) * (1.f / 1024.f) + EPS);
    const f32x4 va = unpk_lo(raw) * rs * *(const GAS f32x4*)(P.vnorm + ch), vb = unpk_hi(raw) * rs * *(const GAS f32x4*)(P.vnorm + ch + 4);
    float* d = P.out + O_NGS + (size_t)(P.layer * 128 + sb) * 1024 + ch;
    *(GAS f32x4*)d = va; *(GAS f32x4*)(d + 4) = vb;
    const float w00 = P.wsp[(size_t)g * 16384], b0 = P.bsp[g * 128];
    *(GAS u32x4*)(P.OC + off) = pk8(unpk_lo(uw) * (va * w00 + b0), unpk_hi(uw) * (vb * w00 + b0));
}
__device__ __forceinline__ void sattn_task(LAS float* wl, const MixP& P, int sb, int kvh, int lane) {
    const size_t row = (size_t)(TP + sb);
    LAS float* qs = wl; LAS float* ps = wl + 256;
    { const u32x2 qw = *(const GAS u32x2*)(P.Q + row * 1024 + kvh * 256 + lane * 4);
      *(LAS f32x4*)(qs + lane * 4) = (f32x4){bflo(qw.x), bfhi(qw.x), bflo(qw.y), bfhi(qw.y)}; }
    LDS_WAIT();
    float slope[4], sink[4];
#pragma unroll
    for (int g = 0; g < 4; ++g) { slope[g] = exp2f(-0.5f * (float)(kvh * 4 + g + 1)); sink[g] = P.sinks[kvh * 4 + g]; }
    float s[2][4];
#pragma unroll
    for (int kk = 0; kk < 2; ++kk) {
        const int j = lane + 64 * kk;
        const float* kr = P.ck + ((size_t)(sb * 128 + j) * 4 + kvh) * 64;
        float a[4] = {0.f, 0.f, 0.f, 0.f};
        f32x4 kreg[16];
#pragma unroll
        for (int c = 0; c < 16; ++c) kreg[c] = __builtin_nontemporal_load((const GAS f32x4*)(kr + 4 * c));
#pragma unroll
        for (int c = 0; c < 16; ++c) { const f32x4 kv = kreg[c];
#pragma unroll
            for (int g = 0; g < 4; ++g) { const f32x4 qv = *(const LAS f32x4*)(qs + g * 64 + 4 * c); a[g] += (kv[0] * qv[0] + kv[1] * qv[1]) + (kv[2] * qv[2] + kv[3] * qv[3]); }
            if (c & 1) __builtin_amdgcn_sched_barrier(0); }
#pragma unroll
        for (int g = 0; g < 4; ++g) s[kk][g] = (j >= 1) ? a[g] - slope[g] * (float)(128 - j) : -1e30f;
        asm volatile("" ::: "memory");
    }
    const float kn = bflo((unsigned)P.Kb[row * 256 + kvh * 64 + lane]);
    const float vn = bflo((unsigned)P.Vb[row * 256 + kvh * 64 + lane]);
    float o[4], inv[4];
#pragma unroll
    for (int g = 0; g < 4; ++g) {
        const float sn = wave_sum(kn * qs[g * 64 + lane]);
        float mx = wave_max(fmaxf(s[0][g], s[1][g])); mx = fmaxf(mx, fmaxf(sn, sink[g]));
        const float p0 = __expf(s[0][g] - mx), p1 = __expf(s[1][g] - mx), pn = __expf(sn - mx);
        const float sum = wave_sum(p0 + p1) + pn + __expf(sink[g] - mx);
        inv[g] = 1.f / sum;
        ps[g * 132 + lane] = p0; ps[g * 132 + 64 + lane] = p1;
        o[g] = pn * vn;
    }
    LDS_WAIT();
    const float* vr = P.cv + ((size_t)(sb * 128) * 4 + kvh) * 64 + lane;
#pragma unroll 1
    for (int jb = 0; jb < 8; ++jb) {
        float v[16];
#pragma unroll
        for (int e = 0; e < 16; ++e) v[e] = __builtin_nontemporal_load((const GAS float*)vr + (size_t)(16 * jb + e) * 256);
#pragma unroll
        for (int j4 = 0; j4 < 4; ++j4)
#pragma unroll
            for (int g = 0; g < 4; ++g) { const f32x4 pp = *(const LAS f32x4*)(ps + g * 132 + 16 * jb + 4 * j4); o[g] += (pp[0] * v[4 * j4] + pp[1] * v[4 * j4 + 1]) + (pp[2] * v[4 * j4 + 2] + pp[3] * v[4 * j4 + 3]); }
        __builtin_amdgcn_sched_barrier(0);
    }
#pragma unroll
    for (int g = 0; g < 4; ++g) P.OA[row * 1024 + (kvh * 4 + g) * 64 + lane] = (bf16_t)(pk(o[g] * inv[g], 0.f) & 0xffff);
    LDS_WAIT();
}
constexpr int MU_ATT = 256, MU_GM = MU_ATT + 512;
#ifndef PROBE_MIX
#define PROBE_MIX 0
#endif
__device__ __forceinline__ void mixers_phase(LAS unsigned char* lds, const MixP& P) {
    for (int u = blockIdx.x; u < MU_GM; u += gridDim.x) {
        if (u < MU_ATT) { attn_unit(lds, P, u >> 6, (u >> 2) & 15, u & 3); if (PROBE_MIX & 1) attn_unit(lds, P, u >> 6, (u >> 2) & 15, u & 3); }
        else { const int v = u - MU_ATT; gmlp_unit(lds, P, v >> 7, (v >> 3) & 15, v & 7); if (PROBE_MIX & 2) gmlp_unit(lds, P, v >> 7, (v >> 3) & 15, v & 7); }
    }
    const int tid = otid(), wid = tid >> 6, lane = tid & 63;
    if (wid < 2) {
        for (int id = blockIdx.x * 2 + wid; id < 512; id += gridDim.x * 2) sattn_task((LAS float*)(lds + wid * 4096), P, id >> 2, id & 3, lane);
    } else {
        const int t6 = tid - 128, stride = gridDim.x * 384;
        for (int it = blockIdx.x * 384 + t6; it < MTOT * 128; it += stride) conv_item(P, it >> 7, (it & 127) * 8);
        for (int it = blockIdx.x * 384 + t6; it < 128 * 128; it += stride) sgmlp_item(P, it >> 7, (it & 127) * 8);
    }
}

#define XB_TMO      128
#define XB_XCNT(j)  (256  + 64 * (j))
#define XB_XSUB(j)  (1280 + 64 * (j))
#define XB_XGEN(j)  (2304 + 64 * (j))
#define XB_TOP      3328
#define XB_TOPGEN   3392
#define XCD_BAR_WORDS 3456
#define XB_SPIN_CAP (1u << 18)

__device__ __forceinline__ unsigned xb_ld(unsigned* p)              { return __hip_atomic_load(p, __ATOMIC_RELAXED, __HIP_MEMORY_SCOPE_AGENT); }
__device__ __forceinline__ unsigned xb_add(unsigned* p, unsigned v) { return __hip_atomic_fetch_add(p, v, __ATOMIC_RELAXED, __HIP_MEMORY_SCOPE_AGENT); }
__device__ __forceinline__ unsigned xb_xcc_id() { return (unsigned)__builtin_amdgcn_s_getreg((3 << 11) | 20) & 0xFu; }
#define XB_SPIN(cond, bar) do { unsigned _sp = 0; while (cond) { __builtin_amdgcn_s_sleep(1); \
    if ((++_sp & 255u) == 0u) { if (xb_ld(&(bar)[XB_TMO])) break; if (_sp > XB_SPIN_CAP) { atomicAdd(&(bar)[XB_TMO], 1u); break; } } } } while (0)

struct XcdBarrier {
    unsigned* bar; unsigned x;
    volatile LAS unsigned* st;
};

__device__ __forceinline__ XcdBarrier xcd_barrier_post(unsigned* bar, volatile LAS unsigned* st) {
    XcdBarrier b; b.bar = bar; b.x = xb_xcc_id(); b.st = st;
    if (threadIdx.x == 0) (void)xb_add(&bar[XB_XCNT(b.x)], 1u);
    return b;
}
__device__ __forceinline__ void xcd_barrier_complete(unsigned* bar, unsigned x, unsigned& nloc, unsigned& nx) {
    const unsigned G = gridDim.x * gridDim.y * gridDim.z;
    unsigned sum, cnt, mine, sp = 0u;
    for (;;) {
        sum = 0u; cnt = 0u; mine = 0u;
#pragma unroll
        for (unsigned j = 0; j < 16; ++j) { const unsigned c = xb_ld(&bar[XB_XCNT(j)]); sum += c; cnt += (c > 0u) ? 1u : 0u; mine = (j == x) ? c : mine; }
        if (sum == G) break;
        __builtin_amdgcn_s_sleep(1);
        if ((++sp & 255u) == 0u) { if (xb_ld(&bar[XB_TMO])) break; if (sp > XB_SPIN_CAP) { atomicAdd(&bar[XB_TMO], 1u); break; } }
    }
    nloc = mine > 0u ? mine : 1u; nx = cnt > 0u ? cnt : 1u;
}

__device__ __forceinline__ void xcd_barrier(const XcdBarrier& b) {
    asm volatile("s_waitcnt vmcnt(0)" ::: "memory");
    __syncthreads();
    if (threadIdx.x == 0) {
        unsigned* bar = b.bar;
        __builtin_amdgcn_s_waitcnt(0);
        unsigned nloc = b.st[0], nx = b.st[1];
        if (nloc == 0u) { xcd_barrier_complete(bar, b.x, nloc, nx); b.st[0] = nloc; b.st[1] = nx; }
        const unsigned old = xb_add(&bar[XB_XSUB(b.x)], 1u);
        const unsigned gen = old / nloc;
        if (old + 1u == (gen + 1u) * nloc) {
            __builtin_amdgcn_fence(__ATOMIC_RELEASE, "agent");
            asm volatile("s_waitcnt vmcnt(0)" ::: "memory");
            const unsigned og = xb_add(&bar[XB_TOP], 1u);
            const unsigned tg = og / nx;
            if (og + 1u == (tg + 1u) * nx) xb_add(&bar[XB_TOPGEN], 1u);
            else XB_SPIN(xb_ld(&bar[XB_TOPGEN]) == tg, bar);
            __builtin_amdgcn_fence(__ATOMIC_ACQUIRE, "agent");
            xb_add(&bar[XB_XGEN(b.x)], 1u);
            asm volatile("s_waitcnt vmcnt(0)" ::: "memory");
        } else {
            XB_SPIN(xb_ld(&bar[XB_XGEN(b.x)]) == gen, bar);
            __builtin_amdgcn_fence(__ATOMIC_ACQUIRE, "agent");
            asm volatile("s_waitcnt vmcnt(0)" ::: "memory");
        }
    }
    __syncthreads();
}

struct Args { const float* in[20]; float* out; unsigned char* ws; };
constexpr int BUBBLE_ITEMS = 96, BUB_A_BLK0 = 1650 % 256, BUB_B_BLK0 = 1452 % 256;
constexpr int BUB_B_N = (256 - BUB_B_BLK0) * BUBBLE_ITEMS;
constexpr int POOL_LO = I_IN, POOL_HI = 2 * I_LAYER - BUB_B_N, POOL_N7 = 146, POOL_N6 = 226;
static_assert(BUB_A_BLK0 * POOL_N7 + (256 - BUB_A_BLK0) * POOL_N6 <= POOL_HI - POOL_LO && POOL_HI - POOL_LO - (BUB_A_BLK0 * POOL_N7 + (256 - BUB_A_BLK0) * POOL_N6) < 64 && BUB_B_N % 8 == 0, "conversion pool split");
#define PH_BEGIN \
    const int tid = otid(), lane = tid & 63, wid = __builtin_amdgcn_readfirstlane(tid >> 6), gw = blockIdx.x * 8 + wid; (void)lane; (void)gw; \
    const int G = gridDim.x, NGW = G * 8; (void)NGW; \
    unsigned char* ws = a.ws; asm volatile("" : "+s"(ws)); \
    const bf16_t* wl = (const bf16_t*)(ws + WS_W) + (size_t)L * WE_LAYER; (void)wl;
#define WSP(T, off) ((T*)(ws + (off)))
template <int L> __device__ __forceinline__ void run_layer(const Args& a, LAS unsigned char* lds, const XcdBarrier& bar) {
    {
        PH_BEGIN
        pg8::Gemm g{WSP(bf16_t, WS_XN), wl, MPAD, INC, DM, 0, 0}; pg8::StaticOrder S; S.init(MPAD, INC, DM, G, (int)blockIdx.x);
        EpiIn E{WSP(bf16_t, WS_Q), WSP(bf16_t, WS_K), WSP(bf16_t, WS_V), WSP(bf16_t, WS_BG), WSP(bf16_t, WS_ZC), WSP(bf16_t, WS_U), WSP(bf16_t, WS_VG), WSP(bf16_t, WS_GT), WSP(float, WS_SSV),
                a.in[8] + L * 64, a.in[9] + L * 64, a.in[7] + L * 6144, a.out, L, WSP(float, WS_RSTD)};
        const int bx = (int)blockIdx.x;
        const bool pool = (L == 0 && G == 256);
        const int plo = POOL_LO + (bx < BUB_A_BLK0 ? bx * POOL_N7 : BUB_A_BLK0 * POOL_N7 + (bx - BUB_A_BLK0) * POOL_N6);
        const int phi = bx == 255 ? POOL_HI : plo + (bx < BUB_A_BLK0 ? POOL_N7 : POOL_N6);
        const CvtSrc cs{a.in[6], a.in[15], a.in[16], a.in[18], a.in[19], WSP(bf16_t, WS_W), a.in[5], a.in[17]};
        if (pool && !(bx & 1)) { convert_weights(cs, plo, phi, (LAS float*)(lds + wid * 16384), wid, 8, lane); __syncthreads(); }
        pg8::gemm_phase<EpiIn, pg8::StaticOrder, true, true>(lds, g, S, E);
        if (pool && (bx & 1)) convert_weights(cs, plo, phi, (LAS float*)(lds + wid * 16384), wid, 8, lane);
    }
    xcd_barrier(bar);
    {
        PH_BEGIN
        MixP P{WSP(bf16_t, WS_Q), WSP(bf16_t, WS_K), WSP(bf16_t, WS_V), WSP(bf16_t, WS_BG), WSP(bf16_t, WS_ZC), WSP(bf16_t, WS_U), WSP(bf16_t, WS_VG), WSP(bf16_t, WS_OA), WSP(bf16_t, WS_OB), WSP(bf16_t, WS_OC), WSP(float, WS_SSV),
               a.in[2] + (size_t)L * 128 * 128 * 256, a.in[3] + (size_t)L * 128 * 128 * 256, a.in[4] + (size_t)L * 128 * 2048, a.in[10] + L * 16, a.in[11] + L * 3072, a.in[12] + L * 1024,
               a.in[13] + (size_t)L * 8 * 16384, a.in[14] + L * 1024, a.out, L};
        mixers_phase(lds, P);
    }
    xcd_barrier(bar);
    {
        PH_BEGIN
        if (G == 256) {
            pg8::Gemm g{WSP(bf16_t, WS_OA), wl + WE_IN, MPAD, DM, 1024, (size_t)MPAD * 1024 * 2, (size_t)2048 * 1024 * 2}; pg8::BranchOrder S; S.init(DM, 1024, G, (int)blockIdx.x);
            EpiBranch E{WSP(bf16_t, WS_GT), WSP(bf16_t, WS_MG), WSP(float, WS_PART), WSP(unsigned, WS_CNT) + (L * 3 + 0) * 512};
            pg8::gemm_phase<EpiBranch, pg8::BranchOrder, true, true>(lds, g, S, E);
        } else {
            for (int bi = 0; bi < 3; ++bi) {
                pg8::Gemm g{WSP(bf16_t, WS_OA) + (size_t)bi * MPAD * 1024, wl + WE_IN + (size_t)bi * 2048 * 1024, MPAD, DM, 1024, 0, 0}; pg8::TailOrder S; S.init(TP, DM, 1024, G, (int)blockIdx.x);
                EpiBranch1 E{WSP(bf16_t, WS_GT), WSP(bf16_t, WS_MG), WSP(float, WS_PART), WSP(unsigned, WS_CNT) + (L * 3 + 0) * 512, bi};
                pg8::gemm_phase<EpiBranch1, pg8::TailOrder, true, true>(lds, g, S, E);
            }
        }
    }
    xcd_barrier(bar);
    {
        PH_BEGIN
        pg8::Gemm g{WSP(bf16_t, WS_MG), wl + WE_IN + WE_BR, MPAD, DM, DM, 0, 0}; pg8::TailOrder S; S.init(TP, DM, DM, G, (int)blockIdx.x);
        EpiRes E{1, a.in[0], a.in[1] - (size_t)TP * DM, WSP(bf16_t, WS_XN), nullptr, MPAD, WSP(float, WS_PART), WSP(unsigned, WS_CNT) + (L * 3 + 1) * 512, DM / 256,
                 WSP(float, WS_SSQ), WSP(float, WS_RSTD), WSP(unsigned, WS_PCNT) + (L * 2 + 0) * 40 * 64};
        pg8::gemm_phase<EpiRes, pg8::TailOrder, true, true>(lds, g, S, E);
    }
    xcd_barrier(bar);
    {
        PH_BEGIN
        pg8::Gemm g{WSP(bf16_t, WS_XN), wl + WE_IN + WE_BR + WE_OUT, MPAD, 2 * DFF, DM, 0, 0}; pg8::StaticOrder S; S.init(MPAD, 2 * DFF, DM, G, (int)blockIdx.x);
        EpiGU E{WSP(bf16_t, WS_H), WSP(float, WS_RSTD)};
        pg8::gemm_phase<EpiGU, pg8::StaticOrder, true, true>(lds, g, S, E);
        if (L == 0 && G == 256 && (int)blockIdx.x >= BUB_B_BLK0) {
            const CvtSrc cs{a.in[6], a.in[15], a.in[16], a.in[18], a.in[19], WSP(bf16_t, WS_W), a.in[5], a.in[17]};
            convert_weights(cs, POOL_HI, 2 * I_LAYER, (LAS float*)(lds + wid * 16384), ((int)blockIdx.x - BUB_B_BLK0) * 8 + wid, (256 - BUB_B_BLK0) * 8, lane);
        }
    }
    xcd_barrier(bar);
    {
        PH_BEGIN
        pg8::Gemm g{WSP(bf16_t, WS_H), wl + WE_IN + WE_BR + WE_OUT + WE_GU, MPAD, DM, DFF, 0, 0}; pg8::TailOrder S; S.init(TP, DM, DFF, G, (int)blockIdx.x);
        EpiRes E{L == 1 ? 2 : 1, nullptr, nullptr, WSP(bf16_t, WS_XN), a.out, L == 1 ? MTOT : MPAD, WSP(float, WS_PART), WSP(unsigned, WS_CNT) + (L * 3 + 2) * 512, DFF / 256,
                 WSP(float, WS_SSQ), WSP(float, WS_RSTD), WSP(unsigned, WS_PCNT) + (L * 2 + 1) * 40 * 64};
        pg8::gemm_phase<EpiRes, pg8::TailOrder, true, true>(lds, g, S, E);
    }
}
#ifndef PROBE_SYNCS
#define PROBE_SYNCS 0
#endif
__global__ void __launch_bounds__(512, 2) hybrid_fwd(Args a) {
    extern __shared__ __attribute__((aligned(16))) unsigned char lds_raw[];
    LAS unsigned char* lds = (LAS unsigned char*)lds_raw;
    cg::grid_group grid = cg::this_grid();
    volatile LAS unsigned* bst = (volatile LAS unsigned*)(lds + 131072 + 64);
    if (threadIdx.x < 2) bst[threadIdx.x] = 0u;
    __syncthreads();
    const XcdBarrier bar = xcd_barrier_post((unsigned*)(a.ws + WS_BAR), bst);
    grid.sync();
    {
        constexpr int L = 0;
        PH_BEGIN
        { const CvtSrc cs{a.in[6], a.in[15], a.in[16], a.in[18], a.in[19], WSP(bf16_t, WS_W), a.in[5], a.in[17]}; convert_weights(cs, 0, G == 256 ? I_IN : 2 * I_LAYER, (LAS float*)(lds + wid * 16384), gw, NGW, lane); }
        prep_rows(a.in[0], a.in[1], WSP(bf16_t, WS_XN), WSP(float, WS_RSTD), gw, NGW, lane);
    }
    xcd_barrier(bar);
    run_layer<0>(a, lds, bar);
    xcd_barrier(bar);
    run_layer<1>(a, lds, bar);
    for (int i = 0; i < PROBE_SYNCS; ++i) xcd_barrier(bar);
}

extern "C" void kernel_launch(void* const* d_in, const int* in_sizes, int n_in, void* d_out, int out_size, void* d_ws, size_t ws_size, hipStream_t stream) {
    static int grid = 0;
    if (grid == 0) {
        if (n_in != 20 || ws_size < WS_END3) { fprintf(stderr, "kernel_launch: need 20 inputs and %zu bytes of workspace, got %d / %zu\n", (size_t)WS_END3, n_in, ws_size); grid = -1; return; }
        int dev = 0, cus = 0, per_cu = 0;
        if (hipGetDevice(&dev) != hipSuccess || hipDeviceGetAttribute(&cus, hipDeviceAttributeMultiprocessorCount, dev) != hipSuccess) { grid = -1; return; }
        if (hipFuncSetAttribute((const void*)hybrid_fwd, hipFuncAttributeMaxDynamicSharedMemorySize, LDS_BYTES) != hipSuccess) { fprintf(stderr, "kernel_launch: hipFuncSetAttribute failed\n"); grid = -1; return; }
        if (hipOccupancyMaxActiveBlocksPerMultiprocessor(&per_cu, (const void*)hybrid_fwd, 512, LDS_BYTES) != hipSuccess || per_cu < 1) { fprintf(stderr, "kernel_launch: occupancy query says %d\n", per_cu); per_cu = 1; }
        (void)hipGetLastError();
        grid = cus * (per_cu > 1 ? 1 : per_cu);
    }
    if (grid < 0) return;
    if (hipMemsetAsync((char*)d_ws + WS_ZERO_LO, 0, WS_ZERO_BYTES, stream) != hipSuccess) { fprintf(stderr, "kernel_launch: memset failed\n"); return; }
    Args a{};
    for (int i = 0; i < 20; ++i) a.in[i] = (const float*)d_in[i];
    a.out = (float*)d_out; a.ws = (unsigned char*)d_ws;
    void* args[] = {&a};
    hipError_t e = hipLaunchCooperativeKernel((const void*)hybrid_fwd, dim3(grid), dim3(512), args, LDS_BYTES, stream);
    if (e != hipSuccess) fprintf(stderr, "cooperative launch failed: %s (grid %d)\n", hipGetErrorString(e), grid);
}
```
